# Optimizing an MI355X kernel written in HIP

```python
import math
import jax
import jax.numpy as jnp
from jax import lax
import numpy as np

D_MODEL = 1024
BATCH = 8
SEQ = 2048
DEPTH = 2
DEC_BATCH = 16
DEC_SEQ = 4096
PAST_LEN = 128

HEAD_DIM = 64
GRID_W = 64
NA_HEADS = 8
NA_WIN_ROWS = 8
NA_WIN_COLS = 16
NA_QCOLS = 16
NA_KCOLS = 32
GQA_Q_HEADS = 8
GQA_KV_HEADS = 2
AXIAL_THETA = 10000.0
DIFF_HEADS = 8
D_FF = 4 * D_MODEL
ROPE_THETA = 10000.0
Q_BLOCK = 128
NORM_EPS = 1e-6
QK_NORM_EPS = 1e-6
SUBLN_EPS = 1e-5

A_WIDTH = NA_HEADS * HEAD_DIM
B_Q_WIDTH = GQA_Q_HEADS * HEAD_DIM
B_KV_WIDTH = GQA_KV_HEADS * HEAD_DIM
EVEN_IN = 3 * A_WIDTH + B_Q_WIDTH + 2 * B_KV_WIDTH
EVEN_OUT = A_WIDTH + B_Q_WIDTH
EVEN_SPLITS = [A_WIDTH, 2 * A_WIDTH, 3 * A_WIDTH, 3 * A_WIDTH + B_Q_WIDTH,
               3 * A_WIDTH + B_Q_WIDTH + B_KV_WIDTH]
DIFF_WIDTH = 2 * DIFF_HEADS * HEAD_DIM
ODD_IN = 3 * DIFF_WIDTH
ODD_SPLITS = [DIFF_WIDTH, 2 * DIFF_WIDTH]
N_EVEN = (DEPTH + 1) // 2
N_ODD = DEPTH // 2

kernel_name = "hybrid_natten_gqa_diffattn_encoder"


def rmsnorm(x, g, eps=NORM_EPS):
    xf = x.astype(jnp.float32)
    y = xf * lax.rsqrt(jnp.mean(xf * xf, axis=-1, keepdims=True) + eps)
    return (y * g.astype(jnp.float32)).astype(x.dtype)


def rope_angles(pos, dim, theta):
    inv_freq = 1.0 / jnp.power(theta, jnp.arange(0, dim, 2, dtype=jnp.float32) / dim)
    ang = pos.astype(jnp.float32)[:, None] * inv_freq[None, :]
    return jnp.cos(ang), jnp.sin(ang)


def apply_rope(x, cos, sin):
    xf = x.astype(jnp.float32)
    half = xf.shape[-1] // 2
    x1, x2 = xf[..., :half], xf[..., half:]
    c = cos[None, :, None, :]
    s = sin[None, :, None, :]
    return jnp.concatenate([x1 * c - x2 * s, x2 * c + x1 * s], axis=-1).astype(x.dtype)


def apply_axial_rope(x, T):
    t = jnp.arange(T)
    half = x.shape[-1] // 2
    cr, sr = rope_angles(t // GRID_W, half, AXIAL_THETA)
    cc, sc = rope_angles(t % GRID_W, half, AXIAL_THETA)
    return jnp.concatenate([apply_rope(x[..., :half], cr, sr),
                            apply_rope(x[..., half:], cc, sc)], axis=-1)


def split_heads(z, n_heads, head_dim):
    B, T, _ = z.shape
    return z.reshape(B, T, n_heads, head_dim)


def neighbourhood_attention(q, k, v, rpb):
    B, T, H, dh = q.shape
    rows = T // GRID_W
    kr = min(NA_WIN_ROWS, rows)
    n_cb = GRID_W // NA_QCOLS
    qc = np.arange(GRID_W).reshape(n_cb, NA_QCOLS)
    band0 = np.clip(qc[:, 0] - NA_WIN_COLS // 2, 0, GRID_W - NA_KCOLS)
    kc = band0[:, None] + np.arange(NA_KCOLS)
    win0 = np.clip(qc - NA_WIN_COLS // 2, 0, GRID_W - NA_WIN_COLS)
    kcb = kc[:, None, :]
    col_mask = (kcb >= win0[..., None]) & (kcb < win0[..., None] + NA_WIN_COLS)
    dcol = np.clip(kcb - qc[..., None] + (NA_WIN_COLS - 1), 0, 2 * NA_WIN_COLS - 2)
    rpb_col = rpb[:, :, dcol]
    mask6 = jnp.asarray(col_mask)[None, None, :, :, None, :]
    qg = q.reshape(B, rows, GRID_W, H, dh)
    kg = k.reshape(B, rows, GRID_W, H, dh)
    vg = v.reshape(B, rows, GRID_W, H, dh)
    scale = dh ** -0.5

    def one_row(r):
        r0 = jnp.clip(r - kr // 2, 0, rows - kr)
        q_r = lax.dynamic_index_in_dim(qg, r, axis=1, keepdims=False).reshape(B, n_cb, NA_QCOLS, H, dh)
        k_r = lax.dynamic_slice_in_dim(kg, r0, kr, axis=1)[:, :, kc]
        v_r = lax.dynamic_slice_in_dim(vg, r0, kr, axis=1)[:, :, kc]
        s = jnp.einsum('bnqhd,brnkhd->bhnqrk', q_r, k_r).astype(jnp.float32) * scale
        drow = r0 + jnp.arange(kr) - r + (NA_WIN_ROWS - 1)
        bias = jnp.take(rpb_col, drow, axis=1).transpose(0, 2, 3, 1, 4)
        s = jnp.where(mask6, s + bias[None].astype(jnp.float32), -jnp.inf)
        p = jax.nn.softmax(s.reshape(B, H, n_cb, NA_QCOLS, kr * NA_KCOLS), axis=-1)
        p = p.reshape(B, H, n_cb, NA_QCOLS, kr, NA_KCOLS).astype(v.dtype)
        o = jnp.einsum('bhnqrk,brnkhd->bnqhd', p, v_r)
        return o.reshape(B, GRID_W, H, dh)

    out = lax.map(one_row, jnp.arange(rows))
    return out.transpose(1, 0, 2, 3, 4).reshape(B, T, H * dh)


def gqa_attention(q, k, v):
    B, T, Hq, dh = q.shape
    Hkv = k.shape[2]
    G = Hq // Hkv
    nblk = T // Q_BLOCK
    scale = dh ** -0.5
    qb = q.reshape(B, nblk, Q_BLOCK, Hkv, G, dh).transpose(1, 0, 2, 3, 4, 5)

    def one_block(q_blk):
        s = jnp.einsum('bqhgd,bkhd->bhgqk', q_blk, k).astype(jnp.float32) * scale
        p = jax.nn.softmax(s, axis=-1).astype(v.dtype)
        return jnp.einsum('bhgqk,bkhd->bqhgd', p, v)

    out = lax.map(one_block, qb)
    return out.transpose(1, 0, 2, 3, 4, 5).reshape(B, T, Hq * dh)


def diff_attention(q, k, v, lam):
    B, T, H2, dh = q.shape
    H = H2 // 2
    nblk = T // Q_BLOCK
    scale = dh ** -0.5
    qb = q.reshape(B, nblk, Q_BLOCK, H, 2, dh).transpose(1, 0, 2, 3, 4, 5)
    kk = k.reshape(B, T, H, 2, dh)

    def one_block(q_blk):
        s = jnp.einsum('bqhcd,bkhcd->bhcqk', q_blk, kk).astype(jnp.float32) * scale
        p = jax.nn.softmax(s, axis=-1)
        a = (p[:, :, 0] - lam * p[:, :, 1]).astype(v.dtype)
        return jnp.einsum('bhqk,bkhe->bqhe', a, v)

    out = lax.map(one_block, qb)
    return out.transpose(1, 0, 2, 3, 4).reshape(B, T, H, 2 * dh)


def encoder_trunk(x, ln_mix_e, w_in_e, rpb, q_norm_b, k_norm_b, w_out_e,
                  ln_mix_o, w_in_o, lambda_q1, lambda_k1, lambda_q2, lambda_k2, subln_g, w_out_o,
                  ln_mlp, w_up, w_down, ln_f):
    B, T, _ = x.shape
    cos1, sin1 = rope_angles(jnp.arange(T), HEAD_DIM, ROPE_THETA)
    for layer in range(DEPTH):
        j = layer // 2
        if layer % 2 == 0:
            h = rmsnorm(x, ln_mix_e[j])
            proj = h @ w_in_e[j]
            qa, ka, va, qb, kb, vb = jnp.split(proj, EVEN_SPLITS, axis=-1)
            a_out = neighbourhood_attention(split_heads(qa, NA_HEADS, HEAD_DIM),
                                            split_heads(ka, NA_HEADS, HEAD_DIM),
                                            split_heads(va, NA_HEADS, HEAD_DIM), rpb[j])
            qb = apply_axial_rope(rmsnorm(split_heads(qb, GQA_Q_HEADS, HEAD_DIM), q_norm_b[j], QK_NORM_EPS), T)
            kb = apply_axial_rope(rmsnorm(split_heads(kb, GQA_KV_HEADS, HEAD_DIM), k_norm_b[j], QK_NORM_EPS), T)
            b_out = gqa_attention(qb, kb, split_heads(vb, GQA_KV_HEADS, HEAD_DIM))
            x = x + jnp.concatenate([a_out, b_out], axis=-1) @ w_out_e[j]
        else:
            h = rmsnorm(x, ln_mix_o[j])
            proj = h @ w_in_o[j]
            qc, kc, vc = jnp.split(proj, ODD_SPLITS, axis=-1)
            qc = apply_rope(split_heads(qc, 2 * DIFF_HEADS, HEAD_DIM), cos1, sin1)
            kc = apply_rope(split_heads(kc, 2 * DIFF_HEADS, HEAD_DIM), cos1, sin1)
            vc = split_heads(vc, DIFF_HEADS, 2 * HEAD_DIM)
            lam_init = 0.8 - 0.6 * math.exp(-0.3 * layer)
            lam = (jnp.exp(jnp.sum(lambda_q1[j].astype(jnp.float32) * lambda_k1[j].astype(jnp.float32)))
                   - jnp.exp(jnp.sum(lambda_q2[j].astype(jnp.float32) * lambda_k2[j].astype(jnp.float32)))
                   + lam_init)
            o = diff_attention(qc, kc, vc, lam)
            o = rmsnorm(o, subln_g[j], SUBLN_EPS) * (1.0 - lam_init)
            x = x + o.reshape(B, T, DIFF_WIDTH) @ w_out_o[j]
        h = rmsnorm(x, ln_mlp[layer])
        x = x + jnp.square(jax.nn.relu(h @ w_up[layer])) @ w_down[layer]
    return rmsnorm(x, ln_f)


def setup_inputs(seed: int = 0) -> dict:
    key = jax.random.key(seed)
    ks = jax.random.split(key, 24)
    f32 = jnp.float32

    def normal(k, shape, scale):
        return jax.random.normal(k, shape, dtype=f32) * scale

    def gain(k, shape):
        return 1.0 + 0.02 * jax.random.normal(k, shape, dtype=f32)

    return {
        "x_prompt": normal(ks[0], (BATCH, SEQ, D_MODEL), 1.0),
        "x_sample": normal(ks[1], (DEC_BATCH, DEC_SEQ, D_MODEL), 1.0),
        "ln_mix_e": gain(ks[2], (N_EVEN, D_MODEL)),
        "w_in_e": normal(ks[3], (N_EVEN, D_MODEL, EVEN_IN), D_MODEL ** -0.5),
        "rpb": normal(ks[4], (N_EVEN, NA_HEADS, 2 * NA_WIN_ROWS - 1, 2 * NA_WIN_COLS - 1), 0.02),
        "q_norm_b": gain(ks[5], (N_EVEN, HEAD_DIM)),
        "k_norm_b": gain(ks[6], (N_EVEN, HEAD_DIM)),
        "w_out_e": normal(ks[7], (N_EVEN, EVEN_OUT, D_MODEL), EVEN_OUT ** -0.5),
        "ln_mix_o": gain(ks[8], (N_ODD, D_MODEL)),
        "w_in_o": normal(ks[9], (N_ODD, D_MODEL, ODD_IN), D_MODEL ** -0.5),
        "lambda_q1": normal(ks[10], (N_ODD, HEAD_DIM), 0.1),
        "lambda_k1": normal(ks[11], (N_ODD, HEAD_DIM), 0.1),
        "lambda_q2": normal(ks[12], (N_ODD, HEAD_DIM), 0.1),
        "lambda_k2": normal(ks[13], (N_ODD, HEAD_DIM), 0.1),
        "subln_g": gain(ks[14], (N_ODD, 2 * HEAD_DIM)),
        "w_out_o": normal(ks[15], (N_ODD, DIFF_WIDTH, D_MODEL), DIFF_WIDTH ** -0.5),
        "ln_mlp": gain(ks[16], (DEPTH, D_MODEL)),
        "w_up": normal(ks[17], (DEPTH, D_MODEL, D_FF), D_MODEL ** -0.5),
        "w_down": normal(ks[18], (DEPTH, D_FF, D_MODEL), D_FF ** -0.5),
        "ln_f": gain(ks[19], (D_MODEL,)),
    }


def reference(x_prompt, x_sample, ln_mix_e, w_in_e, rpb, q_norm_b, k_norm_b, w_out_e,
              ln_mix_o, w_in_o, lambda_q1, lambda_k1, lambda_q2, lambda_k2, subln_g, w_out_o,
              ln_mlp, w_up, w_down, ln_f):
    y_prompt = encoder_trunk(x_prompt, ln_mix_e, w_in_e, rpb, q_norm_b, k_norm_b, w_out_e,
                             ln_mix_o, w_in_o, lambda_q1, lambda_k1, lambda_q2, lambda_k2, subln_g, w_out_o,
                             ln_mlp, w_up, w_down, ln_f)
    y_sample = encoder_trunk(x_sample, ln_mix_e, w_in_e, rpb, q_norm_b, k_norm_b, w_out_e,
                             ln_mix_o, w_in_o, lambda_q1, lambda_k1, lambda_q2, lambda_k2, subln_g, w_out_o,
                             ln_mlp, w_up, w_down, ln_f)
    return (y_prompt, y_sample)
```

```cpp
#include <hip/hip_runtime.h>
#include <hip/hip_cooperative_groups.h>
#include <cstdio>
#include <cstdint>
namespace cg = cooperative_groups;
namespace pg8 {
#define PG8_LAS __attribute__((address_space(3)))
typedef unsigned short bf16_t;
typedef short bf16x8 __attribute__((ext_vector_type(8)));
typedef float f32x4 __attribute__((ext_vector_type(4)));
typedef unsigned u32x4 __attribute__((ext_vector_type(4)));
constexpr int BM = 256, BK = 64, HALF = 128, HTB = HALF * BK * 2  , STAGE_BYTES = 8 * HTB, NXCD = 8, WGM = 8;

__host__ __device__ __forceinline__ int lds_byte(int r, int c) { const int st = (r >> 4) * 2 + (c >> 5), rr = r & 15, cc = c & 31, ob = rr * 64 + cc * 2; return st * 1024 + (ob ^ (((ob >> 9) & 1) << 5)); }
__host__ __device__ __forceinline__ void stage_rc(int b, int& R, int& C) { const int st = b / 1024, sb = b % 1024, swz = sb ^ (((sb >> 9) & 1) << 5); R = (st >> 1) * 16 + swz / 64; C = (st & 1) * 32 + (swz % 64) / 2; }
__host__ __device__ __forceinline__ int perm32(int rho) { const int n = rho >> 4, i = rho & 15; return 8 * (i >> 2) + 4 * n + (i & 3); }

struct Unit { int pm, pn; };
struct Gemm { const bf16_t* A; const bf16_t* Bt; int M, N, K; };

struct StaticOrder {
    int nM, nN, nwg, G, c;
    __host__ __device__ void init(int M, int N, int G_, int c_) { nM = M / BM; nN = N / BM; nwg = nM * nN; G = G_; c = c_; }
    __host__ __device__ bool next(int i, Unit& u) const {
        const long L = (long)i * G + c; if (L >= nwg) return false;
        int wgid = (int)L; { const int q = nwg / NXCD, r = nwg % NXCD, xcd = wgid % NXCD, off = wgid / NXCD; wgid = (xcd < r ? xcd * (q + 1) : r * (q + 1) + (xcd - r) * q) + off; }
        const int nig = WGM * nN, gid = wgid / nig, fm = gid * WGM, gsz = (nM - fm) < WGM ? (nM - fm) : WGM;
        u.pm = fm + ((wgid % nig) % gsz); u.pn = (wgid % nig) / gsz; return true;
    }
    __device__ __forceinline__ void a_ready(const Unit&) const {}
    __device__ __forceinline__ void done(const Unit&) const {}
};

typedef float f32x2_t __attribute__((ext_vector_type(2))); typedef __bf16 bf16x2_t __attribute__((ext_vector_type(2)));
__device__ __forceinline__ unsigned cvt_pk_bf16(float lo, float hi) { f32x2_t v = {lo, hi}; bf16x2_t b = __builtin_convertvector(v, bf16x2_t); return __builtin_bit_cast(unsigned, b); }
__device__ __forceinline__ float row_rstd(const float* rssp, int row) {
    const f32x4* p = (const f32x4*)(rssp + (size_t)row * 16);
    const f32x4 a = p[0], b = p[1], c = p[2], d = p[3];
    const float s = ((a[0] + a[1]) + (a[2] + a[3])) + ((b[0] + b[1]) + (b[2] + b[3])) + (((c[0] + c[1]) + (c[2] + c[3])) + ((d[0] + d[1]) + (d[2] + d[3])));
    return 1.0f / sqrtf(s * (1.f / 1024.f) + 1e-6f);
}
__device__ __forceinline__ float row_rstd_q(const float* rssp, int row, int fq) {
    const f32x4 a = *(const f32x4*)(rssp + (size_t)row * 16 + 4 * fq);
    float q = (a[0] + a[1]) + (a[2] + a[3]);
    q += __shfl_xor(q, 16); q += __shfl_xor(q, 32);
    return __builtin_amdgcn_rsqf(q * (1.f / 1024.f) + 1e-6f);
}
template <int ACT  > struct EpiBf16 {
    static constexpr bool PERM = true, AFTER_DRAIN = false;
    bf16_t* O; int ldc; const float* rss;
    __device__ __forceinline__ void operator()(const f32x4 (&acc)[2][2][4][2], const Unit& u, int wr, int wc, int fr, int fq) const {
        const int row0 = u.pm * BM + wr * 64 + fr; const int col0 = u.pn * BM + wc * 32 + 8 * fq;
#pragma unroll
        for (int ai = 0; ai < 2; ++ai)
#pragma unroll
            for (int m = 0; m < 4; ++m) { bf16_t* rowp = O + (size_t)(row0 + ai * HALF + m * 16) * ldc + col0;
                const float rstd = row_rstd_q(rss, row0 + ai * HALF + m * 16, fq);
#pragma unroll
                for (int bj = 0; bj < 2; ++bj) { f32x4 v0 = acc[ai][bj][m][0] * rstd, v1 = acc[ai][bj][m][1] * rstd;
                    if (ACT == 2) {
#pragma unroll
                        for (int e = 0; e < 4; ++e) { float a = fmaxf(v0[e], 0.f), b = fmaxf(v1[e], 0.f); v0[e] = a * a; v1[e] = b * b; } }
                    u32x4 w; w.x = cvt_pk_bf16(v0[0], v0[1]); w.y = cvt_pk_bf16(v0[2], v0[3]); w.z = cvt_pk_bf16(v1[0], v1[1]); w.w = cvt_pk_bf16(v1[2], v1[3]);
                    *(u32x4*)(rowp + bj * HALF) = w; } }
    }
};
__host__ __device__ __forceinline__ int proj_phys_to_log(int mode, int n) {
    const int pn = n >> 8, c = n & 255, bj = c >> 7, wc = (c >> 5) & 3, fq = (c >> 3) & 3, e = c & 7;
    const bool axial = (mode == 0) && (pn == 6 || pn == 7 || (pn == 8 && wc < 2));
    const int inner = axial ? ((e < 4) ? 4 * fq + e : 16 + 4 * fq + (e - 4)) : 8 * fq + e;
    return pn * 256 + 64 * wc + 32 * bj + inner;
}
template <int MODE> struct EpiProj {
    static constexpr bool PERM = true, AFTER_DRAIN = false;
    bf16_t* O; int ldc; const float* tabC; const float* tabS; const float* gq; const float* gk; int split; const float* rss;
    __device__ __forceinline__ void operator()(const f32x4 (&acc)[2][2][4][2], const Unit& u, int wr, int wc, int fr, int fq) const {
        const int row0 = u.pm * BM + wr * 64 + fr;
        const int cbase = u.pn * BM + 64 * wc;
        const bool special = (MODE == 1) ? (u.pn < 8) : (u.pn == 6 || u.pn == 7 || (u.pn == 8 && wc < 2));
        const int tmask = (u.pm * BM < split) ? 2047 : 4095;
        if (!special) {
#pragma unroll
            for (int ai = 0; ai < 2; ++ai)
#pragma unroll
                for (int m = 0; m < 4; ++m) { bf16_t* rowp = O + (size_t)(row0 + ai * HALF + m * 16) * ldc + cbase + 8 * fq;
                    const float rs_ = row_rstd_q(rss, row0 + ai * HALF + m * 16, fq);
#pragma unroll
                    for (int bj = 0; bj < 2; ++bj) { const f32x4 v0 = acc[ai][bj][m][0] * rs_, v1 = acc[ai][bj][m][1] * rs_;
                        u32x4 w; w.x = cvt_pk_bf16(v0[0], v0[1]); w.y = cvt_pk_bf16(v0[2], v0[3]); w.z = cvt_pk_bf16(v1[0], v1[1]); w.w = cvt_pk_bf16(v1[2], v1[3]);
                        *(u32x4*)(rowp + 32 * bj) = w; } }
        } else if (MODE == 1) {
#pragma unroll
            for (int ai = 0; ai < 2; ++ai)
#pragma unroll
                for (int m = 0; m < 4; ++m) { const int row = row0 + ai * HALF + m * 16; const int t = row & tmask;
                    const f32x4 c0 = *(const f32x4*)(tabC + t * 32 + 8 * fq), c1 = *(const f32x4*)(tabC + t * 32 + 8 * fq + 4);
                    const f32x4 s0 = *(const f32x4*)(tabS + t * 32 + 8 * fq), s1 = *(const f32x4*)(tabS + t * 32 + 8 * fq + 4);
                    const float rs_ = row_rstd_q(rss, row, fq);
                    const f32x4 a0 = acc[ai][0][m][0] * rs_, a1 = acc[ai][0][m][1] * rs_, b0 = acc[ai][1][m][0] * rs_, b1 = acc[ai][1][m][1] * rs_;
                    const f32x4 x0 = a0 * c0 - b0 * s0, x1 = a1 * c1 - b1 * s1, y0 = b0 * c0 + a0 * s0, y1 = b1 * c1 + a1 * s1;
                    bf16_t* rowp = O + (size_t)row * ldc + cbase + 8 * fq;
                    u32x4 w; w.x = cvt_pk_bf16(x0[0], x0[1]); w.y = cvt_pk_bf16(x0[2], x0[3]); w.z = cvt_pk_bf16(x1[0], x1[1]); w.w = cvt_pk_bf16(x1[2], x1[3]);
                    *(u32x4*)(rowp) = w;
                    w.x = cvt_pk_bf16(y0[0], y0[1]); w.y = cvt_pk_bf16(y0[2], y0[3]); w.z = cvt_pk_bf16(y1[0], y1[1]); w.w = cvt_pk_bf16(y1[2], y1[3]);
                    *(u32x4*)(rowp + 32) = w; }
        } else {
            const float* g = (u.pn == 8) ? gk : gq;
            f32x4 gl[2], gh[2];
#pragma unroll
            for (int bj = 0; bj < 2; ++bj) { gl[bj] = *(const f32x4*)(g + 32 * bj + 4 * fq); gh[bj] = *(const f32x4*)(g + 32 * bj + 16 + 4 * fq); }
#pragma unroll
            for (int ai = 0; ai < 2; ++ai)
#pragma unroll
                for (int m = 0; m < 4; ++m) { const int row = row0 + ai * HALF + m * 16; const int t = row & tmask;
                    const float rs_ = row_rstd_q(rss, row, fq);
                    float ss = 0.f;
#pragma unroll
                    for (int bj = 0; bj < 2; ++bj)
#pragma unroll
                        for (int n = 0; n < 2; ++n) { const f32x4 v = acc[ai][bj][m][n] * rs_; ss += (v[0] * v[0] + v[1] * v[1]) + (v[2] * v[2] + v[3] * v[3]); }
                    ss += __shfl_xor(ss, 16); ss += __shfl_xor(ss, 32);
                    const float rstd = rs_ * __builtin_amdgcn_rsqf(ss * (1.f / 64.f) + 1e-6f);
                    bf16_t* rowp = O + (size_t)row * ldc + cbase + 4 * fq;
#pragma unroll
                    for (int bj = 0; bj < 2; ++bj) { const int pos = (bj == 0) ? (t >> 6) : (t & 63);
                        const f32x4 c = *(const f32x4*)(tabC + pos * 16 + 4 * fq), s = *(const f32x4*)(tabS + pos * 16 + 4 * fq);
                        const f32x4 a = acc[ai][bj][m][0] * rstd * gl[bj], b = acc[ai][bj][m][1] * rstd * gh[bj];
                        const f32x4 x = a * c - b * s, y = b * c + a * s;
                        typedef unsigned u32x2_t __attribute__((ext_vector_type(2)));
                        u32x2_t w; w.x = cvt_pk_bf16(x[0], x[1]); w.y = cvt_pk_bf16(x[2], x[3]); *(u32x2_t*)(rowp + 32 * bj) = w;
                        w.x = cvt_pk_bf16(y[0], y[1]); w.y = cvt_pk_bf16(y[2], y[3]); *(u32x2_t*)(rowp + 32 * bj + 16) = w; } }
        }
    }
};
struct EpiResid {
    static constexpr bool PERM = true, AFTER_DRAIN = false;
    const float* B0; const float* B1; int split; int ldc; bf16_t* H; float* rss;
    __device__ __forceinline__ void operator()(const f32x4 (&acc)[2][2][4][2], const Unit& u, int wr, int wc, int fr, int fq) const {
        const int row0 = u.pm * BM + wr * 64 + fr; const int col0 = u.pn * BM + wc * 32 + 8 * fq;
        const float* src = nullptr;
        if (B0) src = (u.pm * BM < split) ? B0 + (size_t)row0 * ldc + col0 : B1 + (size_t)(row0 - split) * ldc + col0;
        bf16_t* hb = H + (size_t)row0 * ldc + col0;
#pragma unroll
        for (int ai = 0; ai < 2; ++ai)
#pragma unroll
            for (int m = 0; m < 4; ++m) { const size_t ro = (size_t)(ai * HALF + m * 16) * ldc; float ss = 0.f;
#pragma unroll
                for (int bj = 0; bj < 2; ++bj) {
                    f32x4 o0, o1;
                    if (B0) { o0 = *(const f32x4*)(src + ro + bj * HALF); o1 = *(const f32x4*)(src + ro + bj * HALF + 4); }
                    else { const u32x4 hw = *(const u32x4*)(hb + ro + bj * HALF);
                           o0[0] = __uint_as_float(hw.x << 16); o0[1] = __uint_as_float(hw.x & 0xffff0000u); o0[2] = __uint_as_float(hw.y << 16); o0[3] = __uint_as_float(hw.y & 0xffff0000u);
                           o1[0] = __uint_as_float(hw.z << 16); o1[1] = __uint_as_float(hw.z & 0xffff0000u); o1[2] = __uint_as_float(hw.w << 16); o1[3] = __uint_as_float(hw.w & 0xffff0000u); }
                    const f32x4 v0 = o0 + acc[ai][bj][m][0], v1 = o1 + acc[ai][bj][m][1];
                    u32x4 w; w.x = cvt_pk_bf16(v0[0], v0[1]); w.y = cvt_pk_bf16(v0[2], v0[3]); w.z = cvt_pk_bf16(v1[0], v1[1]); w.w = cvt_pk_bf16(v1[2], v1[3]);
                    *(u32x4*)(hb + ro + bj * HALF) = w;
                    ss += ((v0[0] * v0[0] + v0[1] * v0[1]) + (v0[2] * v0[2] + v0[3] * v0[3])) + ((v1[0] * v1[0] + v1[1] * v1[1]) + (v1[2] * v1[2] + v1[3] * v1[3])); }
                ss += __shfl_xor(ss, 16); ss += __shfl_xor(ss, 32); if (fq == 0) rss[(size_t)(row0 + ai * HALF + m * 16) * 16 + 4 * u.pn + wc] = ss; }
    }
};

template <class Epi, class Sched, bool ALIGN_EPI = false, bool SP2 = false>
__device__ __forceinline__ void gemm_phase(PG8_LAS unsigned char* lds, const Gemm g, const Sched& S, const Epi& E) {
    int tid_ = threadIdx.x; asm volatile("" : "+v"(tid_));
    const int tid = tid_, wid = __builtin_amdgcn_readfirstlane(tid >> 6), lane = tid & 63, wr = wid >> 2, wc = wid & 3, fr = lane & 15, fq = lane >> 4;
    const int K = g.K, nt = K / BK;
    unsigned voffA[2], voffB[2];
#pragma unroll
    for (int i = 0; i < 2; ++i) { int R, C; stage_rc(tid * 16 + i * 8192, R, C); const int Rb = Epi::PERM ? ((R & ~31) + perm32(R & 31)) : R;
        voffA[i] = (unsigned)(R * K + C) * 2u; voffB[i] = (unsigned)(Rb * K + C) * 2u; }
    const size_t kstep = (size_t)(BK * 2);
    const size_t hstep = (size_t)HALF * K * 2;
    const size_t tstep = 2 * hstep;
    const unsigned ldsw = (unsigned)wid * 1024u;
    const int aoff = lds_byte(wr * 64 + fr, fq * 8), boff = lds_byte(wc * 32 + fr, fq * 8);
#define PG8_SA(b, h) (((b) * 2 + (h)) * HTB)
#define PG8_SB(b, h) ((4 + (b) * 2 + (h)) * HTB)
#define PG8_STAGE(bufoff, gbase, voff) do { _Pragma("unroll") for (int _i = 0; _i < 2; ++_i) \
        __builtin_amdgcn_global_load_lds((const unsigned*)((const char*)(gbase) + (voff)[_i]), (PG8_LAS unsigned*)(lds + (bufoff) + ldsw + _i * 8192), 16, 0, 0); } while (0)
#define PG8_LDA(dst, b, h) do { _Pragma("unroll") for (int m = 0; m < 4; ++m) _Pragma("unroll") for (int k = 0; k < 2; ++k) dst[m][k] = *(const PG8_LAS bf16x8*)(lds + PG8_SA(b, h) + aoff + m * 2048 + k * 1024); } while (0)
#define PG8_LDB(dst, b, h) do { _Pragma("unroll") for (int n = 0; n < 2; ++n) _Pragma("unroll") for (int k = 0; k < 2; ++k) dst[n][k] = *(const PG8_LAS bf16x8*)(lds + PG8_SB(b, h) + boff + n * 2048 + k * 1024); } while (0)
#define PG8_MMA(ai, bj, At, Bt) do { __builtin_amdgcn_s_setprio(1); _Pragma("unroll") for (int m = 0; m < 4; ++m) _Pragma("unroll") for (int n = 0; n < 2; ++n) _Pragma("unroll") for (int k = 0; k < 2; ++k) \
        acc[ai][bj][m][n] = __builtin_amdgcn_mfma_f32_16x16x32_bf16(Bt[n][k], At[m][k], acc[ai][bj][m][n], 0, 0, 0); __builtin_amdgcn_s_setprio(0); } while (0)
#define PG8_WAIT_V(n) asm volatile("s_waitcnt vmcnt(" #n ")" ::: "memory")
#define PG8_WAIT_L(n) asm volatile("s_waitcnt lgkmcnt(" #n ")" ::: "memory")
#define PG8_BAR __builtin_amdgcn_s_barrier()
#define PG8_SCHED __builtin_amdgcn_sched_barrier(0)
    Unit cur, nxt; int ui = 0;
    if (!S.next(0, cur)) return;
    f32x4 acc[2][2][4][2];
#pragma unroll
    for (int a = 0; a < 2; ++a)
#pragma unroll
        for (int b = 0; b < 2; ++b)
#pragma unroll
            for (int m = 0; m < 4; ++m)
#pragma unroll
                for (int n = 0; n < 2; ++n) acc[a][b][m][n] = (f32x4){0.f, 0.f, 0.f, 0.f};
    bf16x8 At[4][2], B0[2][2], B1[2][2];
    const char* cA = (const char*)g.A + (size_t)cur.pm * tstep; const char* cB = (const char*)g.Bt + (size_t)cur.pn * tstep;
    S.a_ready(cur);
    if constexpr (SP2) {
        PG8_STAGE(PG8_SB(0, 0), cB, voffB); PG8_STAGE(PG8_SB(0, 1), cB + hstep, voffB); PG8_STAGE(PG8_SA(0, 0), cA, voffA); PG8_STAGE(PG8_SA(0, 1), cA + hstep, voffA);
        if (wr == 1) PG8_BAR;
        PG8_WAIT_V(2); PG8_BAR;
        PG8_STAGE(PG8_SB(1, 0), cB + kstep, voffB); PG8_STAGE(PG8_SA(1, 0), cA + kstep, voffA); PG8_STAGE(PG8_SB(1, 1), cB + hstep + kstep, voffB);
        PG8_WAIT_V(6); PG8_BAR;
    } else {
        PG8_STAGE(PG8_SB(0, 0), cB, voffB); PG8_STAGE(PG8_SA(0, 0), cA, voffA); PG8_STAGE(PG8_SB(0, 1), cB + hstep, voffB); PG8_STAGE(PG8_SA(0, 1), cA + hstep, voffA);
        if (wr == 1) PG8_BAR;
        PG8_WAIT_V(4); PG8_BAR;
        PG8_STAGE(PG8_SB(1, 0), cB + kstep, voffB); PG8_STAGE(PG8_SA(1, 0), cA + kstep, voffA); PG8_STAGE(PG8_SB(1, 1), cB + hstep + kstep, voffB);
        PG8_WAIT_V(6); PG8_BAR;
    }
    for (;;) {
        const bool has_next = S.next(ui + 1, nxt);
        const char* nA = has_next ? (const char*)g.A + (size_t)nxt.pm * tstep : cA; const char* nB = has_next ? (const char*)g.Bt + (size_t)nxt.pn * tstep : cB;
        for (int t = 0; t < nt; t += 2) {
            const bool last = (t == nt - 2);
            const char* a1 = cA + (size_t)(t + 1) * kstep;
            const char* a2 = last ? nA : cA + (size_t)(t + 2) * kstep; const char* b2 = last ? nB : cB + (size_t)(t + 2) * kstep;
            const char* a3 = a2 + kstep; const char* b3 = b2 + kstep;
            if (last && has_next) S.a_ready(nxt);
            if constexpr (SP2) {
            PG8_LDB(B0, 0, 0); PG8_LDB(B1, 0, 1); PG8_SCHED; PG8_LDA(At, 0, 0); PG8_STAGE(PG8_SA(1, 1), a1 + hstep, voffA);
            PG8_WAIT_V(8); PG8_WAIT_L(0); PG8_BAR; PG8_MMA(0, 0, At, B0); PG8_MMA(0, 1, At, B1); PG8_BAR; PG8_SCHED;
            PG8_LDA(At, 0, 1); PG8_STAGE(PG8_SB(0, 0), b2, voffB); PG8_STAGE(PG8_SB(0, 1), b2 + hstep, voffB); PG8_STAGE(PG8_SA(0, 0), a2, voffA);
            PG8_WAIT_V(8); PG8_WAIT_L(0); PG8_BAR; PG8_MMA(1, 0, At, B0); PG8_MMA(1, 1, At, B1); PG8_BAR; PG8_SCHED;
            PG8_LDB(B0, 1, 0); PG8_LDB(B1, 1, 1); PG8_SCHED; PG8_LDA(At, 1, 0); PG8_STAGE(PG8_SA(0, 1), a2 + hstep, voffA);
            PG8_WAIT_V(8); PG8_WAIT_L(0); PG8_BAR; PG8_MMA(0, 0, At, B0); PG8_MMA(0, 1, At, B1); PG8_BAR; PG8_SCHED;
            PG8_LDA(At, 1, 1); PG8_STAGE(PG8_SB(1, 0), b3, voffB); PG8_STAGE(PG8_SB(1, 1), b3 + hstep, voffB); PG8_STAGE(PG8_SA(1, 0), a3, voffA);
            PG8_WAIT_V(8); PG8_WAIT_L(0); PG8_BAR; PG8_MMA(1, 0, At, B0); PG8_MMA(1, 1, At, B1); PG8_BAR; PG8_SCHED;
            } else {
            PG8_LDB(B0, 0, 0); PG8_SCHED; PG8_LDA(At, 0, 0); PG8_STAGE(PG8_SA(1, 1), a1 + hstep, voffA);
            PG8_WAIT_L(8); PG8_BAR; PG8_WAIT_L(0); PG8_MMA(0, 0, At, B0); PG8_BAR; PG8_SCHED;
            PG8_LDB(B1, 0, 1); PG8_STAGE(PG8_SB(0, 0), b2, voffB);
            PG8_BAR; PG8_WAIT_L(0); PG8_MMA(0, 1, At, B1); PG8_BAR;
            PG8_LDA(At, 0, 1); PG8_STAGE(PG8_SA(0, 0), a2, voffA);
            PG8_BAR; PG8_WAIT_L(0); PG8_MMA(1, 0, At, B0); PG8_BAR; PG8_SCHED;
            PG8_STAGE(PG8_SB(0, 1), b2 + hstep, voffB);
            PG8_WAIT_V(6); PG8_BAR; PG8_MMA(1, 1, At, B1); PG8_BAR;
            PG8_LDB(B0, 1, 0); PG8_SCHED; PG8_LDA(At, 1, 0); PG8_STAGE(PG8_SA(0, 1), a2 + hstep, voffA);
            PG8_WAIT_L(8); PG8_BAR; PG8_WAIT_L(0); PG8_MMA(0, 0, At, B0); PG8_BAR; PG8_SCHED;
            PG8_LDB(B1, 1, 1); PG8_STAGE(PG8_SB(1, 0), b3, voffB);
            PG8_BAR; PG8_WAIT_L(0); PG8_MMA(0, 1, At, B1); PG8_BAR;
            PG8_LDA(At, 1, 1); PG8_STAGE(PG8_SA(1, 0), a3, voffA);
            PG8_BAR; PG8_WAIT_L(0); PG8_MMA(1, 0, At, B0); PG8_BAR; PG8_SCHED;
            PG8_STAGE(PG8_SB(1, 1), b3 + hstep, voffB);
            PG8_WAIT_V(6); PG8_BAR; PG8_MMA(1, 1, At, B1); PG8_BAR;
            }
        }
        if constexpr (ALIGN_EPI) { if (wr == 0) PG8_BAR; }
        if constexpr (!Epi::AFTER_DRAIN) { E(acc, cur, wr, wc, fr, fq); S.done(cur); }
        if (!has_next) break;
#pragma unroll
        for (int a = 0; a < 2; ++a)
#pragma unroll
            for (int b = 0; b < 2; ++b)
#pragma unroll
                for (int m = 0; m < 4; ++m)
#pragma unroll
                    for (int n = 0; n < 2; ++n) acc[a][b][m][n] = (f32x4){0.f, 0.f, 0.f, 0.f};
        cur = nxt; cA = nA; cB = nB; ++ui;
        if constexpr (ALIGN_EPI) { if (wr == 1) PG8_BAR; }
    }
    PG8_WAIT_V(0);
    if constexpr (!ALIGN_EPI) { if (wr == 0) PG8_BAR; }
    PG8_BAR;
    if constexpr (Epi::AFTER_DRAIN) { E.fused(acc, cur, wr, wc, fr, fq, lds, wid, lane); S.done(cur); }
#undef PG8_SA
#undef PG8_SB
#undef PG8_STAGE
#undef PG8_LDA
#undef PG8_LDB
#undef PG8_MMA
#undef PG8_WAIT_V
#undef PG8_WAIT_L
#undef PG8_BAR
#undef PG8_SCHED
}
}
#define PG8_SP2 true
#define PG8_ALIGN true

typedef unsigned short bf16_t;
typedef short bf16x8 __attribute__((ext_vector_type(8)));
typedef short s16x4 __attribute__((ext_vector_type(4)));
typedef float f32x4 __attribute__((ext_vector_type(4)));
typedef float f32x16 __attribute__((ext_vector_type(16)));
typedef unsigned u32x4 __attribute__((ext_vector_type(4)));
typedef unsigned u32x2 __attribute__((ext_vector_type(2)));
#define LAS __attribute__((address_space(3)))

constexpr int DM = 1024, FF = 4096;
constexpr int MP = 8 * 2048, MS = 16 * 4096, MT = MP + MS;
constexpr int NE = 2304, NO = 3072;
constexpr int NWAVES = 8, NTHREADS = 512;
constexpr size_t MiB = 1u << 20;
constexpr size_t WS_ROPE_C = 0, WS_ROPE_S = 512 * 1024, WS_AX_C = 1 * MiB, WS_AX_S = 1 * MiB + 4096;
constexpr size_t WS_WINE = 2 * MiB;
constexpr size_t WS_WOUTE = WS_WINE + (size_t)NE * DM * 2;
constexpr size_t WS_WINO = WS_WOUTE + (size_t)DM * DM * 2;
constexpr size_t WS_WOUTO = WS_WINO + (size_t)NO * DM * 2;
constexpr size_t WS_WUP = WS_WOUTO + (size_t)DM * DM * 2;
constexpr size_t WS_WDN = WS_WUP + (size_t)2 * FF * DM * 2;
constexpr size_t WS_WEND = WS_WDN + (size_t)2 * FF * DM * 2;
static_assert(WS_WEND <= 52 * MiB, "weights");
constexpr size_t WS_BAR = 1 * MiB + 64 * 1024, BAR_BYTES = 16384;
constexpr size_t WS_RSS = 864 * MiB;
constexpr size_t WS_H = 64 * MiB;
constexpr size_t WS_PROJ = 224 * MiB;
constexpr size_t WS_ATT = 704 * MiB;
constexpr size_t WS_HID = 224 * MiB;
constexpr size_t WS_END = 896 * MiB;
constexpr int LDS_BYTES = 147456;
constexpr size_t RS = (size_t)MT * 16;
constexpr int A_KOFF = 0, A_VOFF = 16384, A_RPB = 49152, A_STASH = 65536;
constexpr float LOG2E = 1.4426950408889634f;

struct Params { const float* in[20]; float* out; unsigned char* ws; };

__device__ __forceinline__ float wave_sum(float v) {
#pragma unroll
    for (int o = 1; o < 64; o <<= 1) v += __shfl_xor(v, o);
    return v;
}
__device__ __forceinline__ unsigned pk2(float lo, float hi) { return pg8::cvt_pk_bf16(lo, hi); }
__device__ __forceinline__ float bf_lo(unsigned u) { return __uint_as_float(u << 16); }
__device__ __forceinline__ float bf_hi(unsigned u) { return __uint_as_float(u & 0xffff0000u); }
__device__ __forceinline__ float bf2f(bf16_t b) { return __uint_as_float(((unsigned)b) << 16); }
__device__ __forceinline__ bf16_t f2bf(float f) { return (bf16_t)(pg8::cvt_pk_bf16(f, 0.f) & 0xffffu); }

__device__ __forceinline__ void transpose_item(const float* W, int K, int N, bf16_t* WT, float* scr, int item, int lane, int pmode, const float* g  ) {
    const int nblk = N / 32, kb = item / nblk, nb = item % nblk, k0 = 64 * kb, n0 = 32 * nb;
    const int ncol = (pmode < 0) ? (n0 + (lane & 31)) : pg8::proj_phys_to_log(pmode, n0 + (lane & 31));
#pragma unroll 8
    for (int i = 0; i < 32; ++i) { const int kk = 2 * i + (lane >> 5); const float gv = g ? g[k0 + kk] : 1.0f; scr[kk * 33 + (lane & 31)] = W[(size_t)(k0 + kk) * N + ncol] * gv; }
    __builtin_amdgcn_s_waitcnt(0); asm volatile("" ::: "memory");
    const int c = lane & 7;
#pragma unroll
    for (int j = 0; j < 4; ++j) { const int n = (lane >> 3) + 8 * j; const float* s = scr + (8 * c) * 33 + n;
        u32x4 o; o.x = pk2(s[0 * 33], s[1 * 33]); o.y = pk2(s[2 * 33], s[3 * 33]); o.z = pk2(s[4 * 33], s[5 * 33]); o.w = pk2(s[6 * 33], s[7 * 33]);
        *(u32x4*)(WT + (size_t)(n0 + n) * K + k0 + 8 * c) = o; }
    __builtin_amdgcn_s_waitcnt(0); asm volatile("" ::: "memory");
}
__device__ __forceinline__ void rms_row_bf16(const float* xrow, const float* g, bf16_t* orow, float* copyrow, int lane) {
    const f32x4* xr = (const f32x4*)xrow + lane;
    f32x4 v[4]; float s = 0.f;
#pragma unroll
    for (int j = 0; j < 4; ++j) { v[j] = xr[64 * j]; s += (v[j].x * v[j].x + v[j].y * v[j].y) + (v[j].z * v[j].z + v[j].w * v[j].w); }
    const float rstd = 1.0f / sqrtf(wave_sum(s) * (1.f / DM) + 1e-6f);
#pragma unroll
    for (int j = 0; j < 4; ++j) { const f32x4 gg = ((const f32x4*)g)[lane + 64 * j];
        u32x2 w; w.x = pk2(v[j].x * rstd * gg.x, v[j].y * rstd * gg.y); w.y = pk2(v[j].z * rstd * gg.z, v[j].w * rstd * gg.w);
        *((u32x2*)orow + lane + 64 * j) = w;
        if (copyrow) ((f32x4*)copyrow)[lane + 64 * j] = v[j]; }
}
__device__ __forceinline__ void cvt_row_bf16(const float* xrow, bf16_t* orow, float* rss_out, int lane) {
    const f32x4* xr = (const f32x4*)xrow + lane;
    f32x4 v[4]; float s = 0.f;
#pragma unroll
    for (int j = 0; j < 4; ++j) { v[j] = xr[64 * j]; s += (v[j].x * v[j].x + v[j].y * v[j].y) + (v[j].z * v[j].z + v[j].w * v[j].w); }
    s = wave_sum(s);
#pragma unroll
    for (int j = 0; j < 4; ++j) { u32x2 w; w.x = pk2(v[j].x, v[j].y); w.y = pk2(v[j].z, v[j].w); *((u32x2*)orow + lane + 64 * j) = w; }
    if (lane < 16) rss_out[lane] = (lane == 0) ? s : 0.f;
}
__device__ __forceinline__ void cvt_row_bf16_x2(const float* xa, const float* xb, bf16_t* oa, bf16_t* ob, float* ra, float* rb, int lane) {
    const f32x4* pa = (const f32x4*)xa + lane; const f32x4* pb = (const f32x4*)xb + lane;
    f32x4 v[4], w[4]; float s = 0.f, q = 0.f;
#pragma unroll
    for (int j = 0; j < 4; ++j) { v[j] = pa[64 * j]; w[j] = pb[64 * j]; }
#pragma unroll
    for (int j = 0; j < 4; ++j) { s += (v[j].x * v[j].x + v[j].y * v[j].y) + (v[j].z * v[j].z + v[j].w * v[j].w); q += (w[j].x * w[j].x + w[j].y * w[j].y) + (w[j].z * w[j].z + w[j].w * w[j].w); }
    s = wave_sum(s); q = wave_sum(q);
#pragma unroll
    for (int j = 0; j < 4; ++j) { u32x2 a; a.x = pk2(v[j].x, v[j].y); a.y = pk2(v[j].z, v[j].w); *((u32x2*)oa + lane + 64 * j) = a;
                                  u32x2 b; b.x = pk2(w[j].x, w[j].y); b.y = pk2(w[j].z, w[j].w); *((u32x2*)ob + lane + 64 * j) = b; }
    if (lane < 16) { ra[lane] = (lane == 0) ? s : 0.f; rb[lane] = (lane == 0) ? q : 0.f; }
}
__device__ __forceinline__ void final_row_x2(const bf16_t* ha, const bf16_t* hb, float rsa, float rsb, const float* g, float* oa, float* ob, int lane) {
    u32x4 x[2], y[2];
#pragma unroll
    for (int j = 0; j < 2; ++j) { x[j] = *((const u32x4*)ha + lane + 64 * j); y[j] = *((const u32x4*)hb + lane + 64 * j); }
#pragma unroll
    for (int j = 0; j < 2; ++j) {
        const f32x4 g0 = *((const f32x4*)g + 2 * (lane + 64 * j)), g1 = *((const f32x4*)g + 2 * (lane + 64 * j) + 1);
        f32x4 o0, o1;
        o0.x = bf_lo(x[j].x) * rsa * g0.x; o0.y = bf_hi(x[j].x) * rsa * g0.y; o0.z = bf_lo(x[j].y) * rsa * g0.z; o0.w = bf_hi(x[j].y) * rsa * g0.w;
        o1.x = bf_lo(x[j].z) * rsa * g1.x; o1.y = bf_hi(x[j].z) * rsa * g1.y; o1.z = bf_lo(x[j].w) * rsa * g1.z; o1.w = bf_hi(x[j].w) * rsa * g1.w;
        *((f32x4*)oa + 2 * (lane + 64 * j)) = o0; *((f32x4*)oa + 2 * (lane + 64 * j) + 1) = o1;
        o0.x = bf_lo(y[j].x) * rsb * g0.x; o0.y = bf_hi(y[j].x) * rsb * g0.y; o0.z = bf_lo(y[j].y) * rsb * g0.z; o0.w = bf_hi(y[j].y) * rsb * g0.w;
        o1.x = bf_lo(y[j].z) * rsb * g1.x; o1.y = bf_hi(y[j].z) * rsb * g1.y; o1.z = bf_lo(y[j].w) * rsb * g1.z; o1.w = bf_hi(y[j].w) * rsb * g1.w;
        *((f32x4*)ob + 2 * (lane + 64 * j)) = o0; *((f32x4*)ob + 2 * (lane + 64 * j) + 1) = o1;
    }
}
__device__ __forceinline__ void final_row(const bf16_t* hrow, float rstd, const float* g, float* orow, int lane) {
#pragma unroll
    for (int j = 0; j < 2; ++j) {
        const u32x4 hw = *((const u32x4*)hrow + lane + 64 * j);
        const f32x4 g0 = *((const f32x4*)g + 2 * (lane + 64 * j)), g1 = *((const f32x4*)g + 2 * (lane + 64 * j) + 1);
        f32x4 o0, o1;
        o0.x = bf_lo(hw.x) * rstd * g0.x; o0.y = bf_hi(hw.x) * rstd * g0.y; o0.z = bf_lo(hw.y) * rstd * g0.z; o0.w = bf_hi(hw.y) * rstd * g0.w;
        o1.x = bf_lo(hw.z) * rstd * g1.x; o1.y = bf_hi(hw.z) * rstd * g1.y; o1.z = bf_lo(hw.w) * rstd * g1.z; o1.w = bf_hi(hw.w) * rstd * g1.w;
        *((f32x4*)orow + 2 * (lane + 64 * j)) = o0; *((f32x4*)orow + 2 * (lane + 64 * j) + 1) = o1;
    }
}
__device__ __forceinline__ void rms_row_f32_inplace(float* xrow, const float* g, int lane) {
    f32x4* xr = (f32x4*)xrow + lane;
    f32x4 v[4]; float s = 0.f;
#pragma unroll
    for (int j = 0; j < 4; ++j) { v[j] = xr[64 * j]; s += (v[j].x * v[j].x + v[j].y * v[j].y) + (v[j].z * v[j].z + v[j].w * v[j].w); }
    const float rstd = 1.0f / sqrtf(wave_sum(s) * (1.f / DM) + 1e-6f);
#pragma unroll
    for (int j = 0; j < 4; ++j) { const f32x4 gg = ((const f32x4*)g)[lane + 64 * j]; f32x4 o; o.x = v[j].x * rstd * gg.x; o.y = v[j].y * rstd * gg.y; o.z = v[j].z * rstd * gg.z; o.w = v[j].w * rstd * gg.w; xr[64 * j] = o; }
}
__device__ __forceinline__ void cs_of(float ang, float& c, float& s) {
    const double rev = (double)ang * 0.15915494309189535; const float fr = (float)(rev - floor(rev));
    c = __builtin_amdgcn_cosf(fr); s = __builtin_amdgcn_sinf(fr);
}

__device__ __forceinline__ int crow(int r, int hi) { return (r & 3) + 8 * (r >> 2) + 4 * hi; }
#define MFMA32(a, b, c) __builtin_amdgcn_mfma_f32_32x32x16_bf16((a), (b), (c), 0, 0, 0)
typedef short v4i16_t __attribute__((ext_vector_type(4)));
__device__ __forceinline__ float max3f(float a, float b, float c) { float r; asm("v_max3_f32 %0, %1, %2, %3" : "=v"(r) : "v"(a), "v"(b), "v"(c)); return r; }
__device__ __forceinline__ s16x4 vtr(const LAS char* p) { return __builtin_bit_cast(s16x4, __builtin_amdgcn_ds_read_tr16_b64_v4i16((LAS v4i16_t*)p)); }

template <int DV, bool NA>
__device__ __forceinline__ void tile_compute(char* lds, int buf, int t, const bf16x8 (&qf)[4], int koff, int vlane, int r32, int hi, float sc, int na_qc0, int na_r,
                                             f32x16 (&o)[DV / 32], float& m_run, float& l_run) {
    constexpr int NDB = DV / 32;
    const char* Kb = lds + A_KOFF + buf * 8192;
    const LAS char* Vb = (const LAS char*)(lds + A_VOFF + buf * 16384 + vlane);
    bf16x8 kf0[4], kf1[4];
    if (NDB == 2) {
#pragma unroll
        for (int d0 = 0; d0 < 4; ++d0) {
            const int off = koff + (((2 * d0 + hi) ^ ((r32 >> 1) & 7)) << 4);
            kf0[d0] = *(const bf16x8*)(Kb + off);
            kf1[d0] = *(const bf16x8*)(Kb + 4096 + off);
        }
    }
    constexpr int NPRE = 2;
    s16x4 vlo[NPRE][4], vhh[NPRE][4];
    if (NDB == 2) {
#pragma unroll
        for (int g = 0; g < NPRE; ++g)
#pragma unroll
            for (int s = 0; s < 4; ++s) { vlo[g][s] = vtr(Vb + g * 4096 + s * 1024); vhh[g][s] = vtr(Vb + g * 4096 + s * 1024 + 512); }
    }
    f32x16 s0, s1;
#pragma unroll
    for (int i = 0; i < 16; ++i) { s0[i] = 0.f; s1[i] = 0.f; }
    if (NDB == 2) {
#pragma unroll
        for (int d0 = 0; d0 < 4; ++d0) { s0 = MFMA32(kf0[d0], qf[d0], s0); s1 = MFMA32(kf1[d0], qf[d0], s1); }
    } else {
#pragma unroll
        for (int d0 = 0; d0 < 4; ++d0) {
            const int off = koff + (((2 * d0 + hi) ^ ((r32 >> 1) & 7)) << 4);
            const bf16x8 k0 = *(const bf16x8*)(Kb + off);
            const bf16x8 k1 = *(const bf16x8*)(Kb + 4096 + off);
            s0 = MFMA32(k0, qf[d0], s0); s1 = MFMA32(k1, qf[d0], s1);
        }
    }
    float mx = -1e30f;
    if (NA) {
        const int qc = na_qc0 + r32; const int win0 = min(max(qc - 8, 0), 48);
        const float* rp = (const float*)(lds + A_RPB) + (t - na_r + 7) * 31 + (15 - qc);
#pragma unroll
        for (int i = 0; i < 16; ++i) {
            const int kc = crow(i, hi), kc1 = kc + 32;
            const bool v0 = (kc >= win0) && (kc < win0 + 16), v1 = (kc1 >= win0) && (kc1 < win0 + 16);
            s0[i] = v0 ? fmaf(s0[i], sc, rp[kc]) : -1e30f;
            s1[i] = v1 ? fmaf(s1[i], sc, rp[kc1]) : -1e30f;
        }
#pragma unroll
        for (int i = 0; i < 16; ++i) mx = max3f(mx, s0[i], s1[i]);
    } else {
        asm volatile("s_nop 15\n\ts_nop 7" : "+v"(s0), "+v"(s1));
#pragma unroll
        for (int i = 0; i < 16; ++i) mx = max3f(mx, s0[i], s1[i]);
        mx *= sc;
    }
    mx = fmaxf(mx, __shfl_xor(mx, 32));
    const float m_new = fmaxf(m_run, mx);
    if (__any(m_new > m_run)) {
        const float alpha = __builtin_amdgcn_exp2f(m_run - m_new);
        l_run *= alpha;
#pragma unroll
        for (int db = 0; db < NDB; ++db)
#pragma unroll
            for (int i = 0; i < 16; ++i) o[db][i] *= alpha;
        m_run = m_new;
    }
    float rs = 0.f;
    if (NA) {
#pragma unroll
        for (int i = 0; i < 16; ++i) { s0[i] = __builtin_amdgcn_exp2f(s0[i] - m_new); s1[i] = __builtin_amdgcn_exp2f(s1[i] - m_new); rs += s0[i] + s1[i]; }
    } else {
#pragma unroll
        for (int i = 0; i < 16; ++i) { s0[i] = __builtin_amdgcn_exp2f(fmaf(s0[i], sc, -m_new)); s1[i] = __builtin_amdgcn_exp2f(fmaf(s1[i], sc, -m_new)); rs += s0[i] + s1[i]; }
    }
    l_run += rs;
    bf16x8 pa[4];
    {
        u32x4 w;
        w.x = pk2(s0[0], s0[1]); w.y = pk2(s0[2], s0[3]); w.z = pk2(s0[4], s0[5]); w.w = pk2(s0[6], s0[7]); pa[0] = __builtin_bit_cast(bf16x8, w);
        w.x = pk2(s0[8], s0[9]); w.y = pk2(s0[10], s0[11]); w.z = pk2(s0[12], s0[13]); w.w = pk2(s0[14], s0[15]); pa[1] = __builtin_bit_cast(bf16x8, w);
        w.x = pk2(s1[0], s1[1]); w.y = pk2(s1[2], s1[3]); w.z = pk2(s1[4], s1[5]); w.w = pk2(s1[6], s1[7]); pa[2] = __builtin_bit_cast(bf16x8, w);
        w.x = pk2(s1[8], s1[9]); w.y = pk2(s1[10], s1[11]); w.z = pk2(s1[12], s1[13]); w.w = pk2(s1[14], s1[15]); pa[3] = __builtin_bit_cast(bf16x8, w);
    }
    if (NDB == 2) {
#pragma unroll
        for (int s = 0; s < 4; ++s) {
            o[0] = MFMA32(__builtin_shufflevector(vlo[0][s], vhh[0][s], 0, 1, 2, 3, 4, 5, 6, 7), pa[s], o[0]);
            o[1] = MFMA32(__builtin_shufflevector(vlo[NPRE - 1][s], vhh[NPRE - 1][s], 0, 1, 2, 3, 4, 5, 6, 7), pa[s], o[1]);
        }
    } else {
        s16x4 clo[4], chh[4];
#pragma unroll
        for (int s = 0; s < 4; ++s) { clo[s] = vtr(Vb + s * 1024); chh[s] = vtr(Vb + s * 1024 + 512); }
#pragma unroll
        for (int db = 0; db < NDB; ++db) {
            s16x4 nlo[4], nhh[4];
            if (db + 1 < NDB) {
#pragma unroll
                for (int s = 0; s < 4; ++s) { nlo[s] = vtr(Vb + (db + 1) * 4096 + s * 1024); nhh[s] = vtr(Vb + (db + 1) * 4096 + s * 1024 + 512); }
            }
#pragma unroll
            for (int s = 0; s < 4; ++s) o[db] = MFMA32(__builtin_shufflevector(clo[s], chh[s], 0, 1, 2, 3, 4, 5, 6, 7), pa[s], o[db]);
            if (db + 1 < NDB) {
#pragma unroll
                for (int s = 0; s < 4; ++s) { clo[s] = nlo[s]; chh[s] = nhh[s]; }
            }
        }
    }
}

template <int DV, bool NA>
__device__ __forceinline__ void flash_pass(char* lds, const bf16_t* Qw, const bf16_t* Kh, const bf16_t* Vh, int pitch,
                                           int tb, int te, int wb, int we, float sc, int na_qc0, int na_r, f32x16 (&o)[DV / 32], float& l_tot) {
    constexpr int NVL = DV / 64, NDB = DV / 32;
    int tid_ = threadIdx.x; asm volatile("" : "+v"(tid_));
    const int tid = tid_, lane = tid & 63, r32 = lane & 31, hi = lane >> 5;
    bf16x8 qf[4];
#pragma unroll
    for (int d0 = 0; d0 < 4; ++d0) qf[d0] = *(const bf16x8*)(Qw + (size_t)r32 * pitch + d0 * 16 + hi * 8);
    float m_run = -1e30f, l_run = 0.f;
#pragma unroll
    for (int db = 0; db < NDB; ++db)
#pragma unroll
        for (int i = 0; i < 16; ++i) o[db][i] = 0.f;
    const int krow = tid >> 3, kch = tid & 7;
    const int kdst = krow * 128 + ((kch ^ ((krow >> 1) & 7)) << 4);
    const bf16_t* ksrc = Kh + (size_t)krow * pitch + kch * 8;
    int vdst[NVL]; const bf16_t* vsrc[NVL];
#pragma unroll
    for (int i = 0; i < NVL; ++i) {
        const int vrow = (NVL == 1) ? (tid >> 3) : ((tid >> 4) + 32 * i), vch = (NVL == 1) ? (tid & 7) : (tid & 15), d = vch * 8;
        vdst[i] = ((d >> 5) * 8 + (vrow >> 3)) * 512 + (vrow & 7) * 64 + (d & 31) * 2;
        vsrc[i] = Vh + (size_t)vrow * pitch + d;
    }
    const size_t tstride = (size_t)64 * pitch;
    u32x4 kA, vA[NVL], kB, vB[NVL];
#define FP_LOAD(K_, V_, tt) do { K_ = *(const u32x4*)(ksrc + (size_t)(tt) * tstride); _Pragma("unroll") for (int i_ = 0; i_ < NVL; ++i_) V_[i_] = *(const u32x4*)(vsrc[i_] + (size_t)(tt) * tstride); } while (0)
#define FP_WRITE(K_, V_, bb) do { *(u32x4*)(lds + A_KOFF + (bb) * 8192 + kdst) = K_; _Pragma("unroll") for (int i_ = 0; i_ < NVL; ++i_) *(u32x4*)(lds + A_VOFF + (bb) * 16384 + vdst[i_]) = V_[i_]; } while (0)
    FP_LOAD(kA, vA, tb);
    FP_WRITE(kA, vA, 0);
    if (tb + 1 < te) FP_LOAD(kA, vA, tb + 1);
    __syncthreads();
    const int koff = r32 * 128;
    const int vlane = (4 * hi + ((lane & 15) >> 2)) * 64 + ((lane >> 4) & 1) * 32 + (lane & 3) * 8;
    for (int t = tb; t < te; t += 2) {
        if (t + 2 < te) FP_LOAD(kB, vB, t + 2);
        if (t >= wb && t < we) tile_compute<DV, NA>(lds, 0, t, qf, koff, vlane, r32, hi, sc, na_qc0, na_r, o, m_run, l_run);
        if (t + 1 < te) FP_WRITE(kA, vA, 1);
        __syncthreads();
        if (t + 1 >= te) break;
        if (t + 3 < te) FP_LOAD(kA, vA, t + 3);
        if (t + 1 >= wb && t + 1 < we) tile_compute<DV, NA>(lds, 1, t + 1, qf, koff, vlane, r32, hi, sc, na_qc0, na_r, o, m_run, l_run);
        if (t + 2 < te) FP_WRITE(kB, vB, 0);
        __syncthreads();
    }
#undef FP_LOAD
#undef FP_WRITE
    l_tot = l_run + __shfl_xor(l_run, 32);
}

#define VTR_ASM(dst, addr, off) asm volatile("ds_read_b64_tr_b16 %0, %1 offset:%2" : "=&v"(dst) : "v"(addr), "i"(off) : "memory")
#define VSET_WAIT(L, H) asm volatile("s_waitcnt lgkmcnt(0)" : "+v"(L[0]), "+v"(L[1]), "+v"(L[2]), "+v"(L[3]), "+v"(H[0]), "+v"(H[1]), "+v"(H[2]), "+v"(H[3]) :: "memory")
template <int DV, int KOFFB, int VOFFB>
__device__ __forceinline__ void dense_step(char* lds, const bf16x8 (&qf)[4], int koff, int vlane, int r32, int hi, float sc,
                                           f32x16& s0, f32x16& s1, f32x16 (&o)[DV / 32], float& m_run, float& l_run) {
    constexpr int NDB = DV / 32;
    const char* Kb = lds + KOFFB;
    const LAS char* Vb = (const LAS char*)(lds + VOFFB + vlane);
    const unsigned vaddr = (unsigned)(uintptr_t)(lds + vlane);
    constexpr int VO = VOFFB;
    bf16x8 kf0[4], kf1[4];
#pragma unroll
    for (int d0 = 0; d0 < 4; ++d0) {
        const int off = koff + (((2 * d0 + hi) ^ ((r32 >> 1) & 7)) << 4);
        kf0[d0] = *(const bf16x8*)(Kb + off);
        kf1[d0] = *(const bf16x8*)(Kb + 4096 + off);
    }
    s16x4 vlo[2][4], vhh[2][4];
    if (NDB == 2) {
#pragma unroll
        for (int g = 0; g < 2; ++g)
#pragma unroll
            for (int s = 0; s < 4; ++s) { vlo[g][s] = vtr(Vb + g * 4096 + s * 1024); vhh[g][s] = vtr(Vb + g * 4096 + s * 1024 + 512); }
    }
    asm volatile("s_nop 15\n\ts_nop 7" : "+v"(s0), "+v"(s1));
    float mx = -1e30f, mxb = -1e30f;
#pragma unroll
    for (int i = 0; i < 16; i += 2) { mx = max3f(mx, s0[i], s1[i]); mxb = max3f(mxb, s0[i + 1], s1[i + 1]); }
    mx = fmaxf(mx, mxb) * sc;
    mx = fmaxf(mx, __shfl_xor(mx, 32));
    const float m_new = fmaxf(m_run, mx);
    if (__any(m_new > m_run)) {
        const float alpha = __builtin_amdgcn_exp2f(m_run - m_new);
        l_run *= alpha;
#pragma unroll
        for (int db = 0; db < NDB; ++db)
#pragma unroll
            for (int i = 0; i < 16; ++i) o[db][i] *= alpha;
        m_run = m_new;
    }
    s16x4 alo[4], ahh[4], blo[4], bhh[4];
    if (NDB == 4) {
        VTR_ASM(alo[0], vaddr, VO + 0 * 4096); VTR_ASM(ahh[0], vaddr, VO + 0 * 4096 + 512); VTR_ASM(alo[1], vaddr, VO + 1 * 4096); VTR_ASM(ahh[1], vaddr, VO + 1 * 4096 + 512);
        VTR_ASM(alo[2], vaddr, VO + 2 * 4096); VTR_ASM(ahh[2], vaddr, VO + 2 * 4096 + 512); VTR_ASM(alo[3], vaddr, VO + 3 * 4096); VTR_ASM(ahh[3], vaddr, VO + 3 * 4096 + 512);
    }
    f32x16 n0, n1;
#pragma unroll
    for (int i = 0; i < 16; ++i) { n0[i] = 0.f; n1[i] = 0.f; }
#pragma unroll
    for (int d0 = 0; d0 < 4; ++d0) { n0 = MFMA32(kf0[d0], qf[d0], n0); n1 = MFMA32(kf1[d0], qf[d0], n1); }
    float rs = 0.f;
#pragma unroll
    for (int i = 0; i < 16; ++i) { s0[i] = __builtin_amdgcn_exp2f(fmaf(s0[i], sc, -m_new)); s1[i] = __builtin_amdgcn_exp2f(fmaf(s1[i], sc, -m_new)); rs += s0[i] + s1[i]; }
    l_run += rs;
    bf16x8 pa[4];
    {
        u32x4 w;
        w.x = pk2(s0[0], s0[1]); w.y = pk2(s0[2], s0[3]); w.z = pk2(s0[4], s0[5]); w.w = pk2(s0[6], s0[7]); pa[0] = __builtin_bit_cast(bf16x8, w);
        w.x = pk2(s0[8], s0[9]); w.y = pk2(s0[10], s0[11]); w.z = pk2(s0[12], s0[13]); w.w = pk2(s0[14], s0[15]); pa[1] = __builtin_bit_cast(bf16x8, w);
        w.x = pk2(s1[0], s1[1]); w.y = pk2(s1[2], s1[3]); w.z = pk2(s1[4], s1[5]); w.w = pk2(s1[6], s1[7]); pa[2] = __builtin_bit_cast(bf16x8, w);
        w.x = pk2(s1[8], s1[9]); w.y = pk2(s1[10], s1[11]); w.z = pk2(s1[12], s1[13]); w.w = pk2(s1[14], s1[15]); pa[3] = __builtin_bit_cast(bf16x8, w);
    }
    if (NDB == 2) {
#pragma unroll
        for (int s = 0; s < 4; ++s) {
            o[0] = MFMA32(__builtin_shufflevector(vlo[0][s], vhh[0][s], 0, 1, 2, 3, 4, 5, 6, 7), pa[s], o[0]);
            o[1] = MFMA32(__builtin_shufflevector(vlo[1][s], vhh[1][s], 0, 1, 2, 3, 4, 5, 6, 7), pa[s], o[1]);
        }
        s0 = n0; s1 = n1;
#pragma unroll
        for (int i = 0; i < 16; ++i) { __builtin_amdgcn_sched_group_barrier(0x008, 1, 0); __builtin_amdgcn_sched_group_barrier(0x002, 6, 0); }
    } else {
#pragma unroll
        for (int i = 0; i < 8; ++i) { __builtin_amdgcn_sched_group_barrier(0x008, 1, 0); __builtin_amdgcn_sched_group_barrier(0x002, 12, 0); }
        __builtin_amdgcn_sched_barrier(0);
#define PV4(L, H, S_) do { _Pragma("unroll") for (int db_ = 0; db_ < 4; ++db_) o[db_] = MFMA32(__builtin_shufflevector(L[db_], H[db_], 0, 1, 2, 3, 4, 5, 6, 7), pa[S_], o[db_]); } while (0)
#define VRD4(L, H, S_) do { VTR_ASM(L[0], vaddr, VO + 0 * 4096 + (S_) * 1024); VTR_ASM(H[0], vaddr, VO + 0 * 4096 + (S_) * 1024 + 512); VTR_ASM(L[1], vaddr, VO + 1 * 4096 + (S_) * 1024); VTR_ASM(H[1], vaddr, VO + 1 * 4096 + (S_) * 1024 + 512); \
                             VTR_ASM(L[2], vaddr, VO + 2 * 4096 + (S_) * 1024); VTR_ASM(H[2], vaddr, VO + 2 * 4096 + (S_) * 1024 + 512); VTR_ASM(L[3], vaddr, VO + 3 * 4096 + (S_) * 1024); VTR_ASM(H[3], vaddr, VO + 3 * 4096 + (S_) * 1024 + 512); } while (0)
        VSET_WAIT(alo, ahh); VRD4(blo, bhh, 1); __builtin_amdgcn_sched_barrier(0);
        PV4(alo, ahh, 0); __builtin_amdgcn_sched_barrier(0);
        VSET_WAIT(blo, bhh); VRD4(alo, ahh, 2); __builtin_amdgcn_sched_barrier(0);
        PV4(blo, bhh, 1); __builtin_amdgcn_sched_barrier(0);
        VSET_WAIT(alo, ahh); VRD4(blo, bhh, 3); __builtin_amdgcn_sched_barrier(0);
        PV4(alo, ahh, 2); __builtin_amdgcn_sched_barrier(0);
        VSET_WAIT(blo, bhh); __builtin_amdgcn_sched_barrier(0);
        PV4(blo, bhh, 3);
#undef PV4
#undef VRD4
        s0 = n0; s1 = n1;
    }
}

template <int DV>
__device__ __forceinline__ void flash_pass_dense(char* lds, const bf16_t* Qw, const bf16_t* Kh, const bf16_t* Vh, int pitch, int NT, float sc,
                                                 f32x16 (&o)[DV / 32], float& l_tot) {
    constexpr int NVL = DV / 64, NDB = DV / 32;
    int tid_ = threadIdx.x; asm volatile("" : "+v"(tid_));
    const int tid = tid_, lane = tid & 63, r32 = lane & 31, hi = lane >> 5;
    if (__builtin_amdgcn_readfirstlane(tid >> 6) >= 4) __builtin_amdgcn_s_setprio(1);
    bf16x8 qf[4];
#pragma unroll
    for (int d0 = 0; d0 < 4; ++d0) qf[d0] = *(const bf16x8*)(Qw + (size_t)r32 * pitch + d0 * 16 + hi * 8);
    float m_run = -1e30f, l_run = 0.f;
#pragma unroll
    for (int db = 0; db < NDB; ++db)
#pragma unroll
        for (int i = 0; i < 16; ++i) o[db][i] = 0.f;
    const int krow = tid >> 3, kch = tid & 7;
    const int kdst = krow * 128 + ((kch ^ ((krow >> 1) & 7)) << 4);
    const bf16_t* ksrc = Kh + (size_t)krow * pitch + kch * 8;
    int vdst[NVL]; const bf16_t* vsrc[NVL];
#pragma unroll
    for (int i = 0; i < NVL; ++i) {
        const int vrow = (NVL == 1) ? (tid >> 3) : ((tid >> 4) + 32 * i), vch = (NVL == 1) ? (tid & 7) : (tid & 15), d = vch * 8;
        vdst[i] = ((d >> 5) * 8 + (vrow >> 3)) * 512 + (vrow & 7) * 64 + (d & 31) * 2;
        vsrc[i] = Vh + (size_t)vrow * pitch + d;
    }
    const size_t tstride = (size_t)64 * pitch;
    const int last = NT - 1;
    u32x4 kA, vA[NVL], kB, vB[NVL];
#define FD_LOADK(K_, tt) do { K_ = *(const u32x4*)(ksrc + (size_t)min((tt), last) * tstride); } while (0)
#define FD_LOADV(V_, tt) do { _Pragma("unroll") for (int i_ = 0; i_ < NVL; ++i_) V_[i_] = *(const u32x4*)(vsrc[i_] + (size_t)min((tt), last) * tstride); } while (0)
#define FD_WRITEK(K_, bb) do { *(u32x4*)(lds + A_KOFF + (bb) * 8192 + kdst) = K_; } while (0)
#define FD_WRITEV(V_, bb) do { _Pragma("unroll") for (int i_ = 0; i_ < NVL; ++i_) *(u32x4*)(lds + A_VOFF + (bb) * 16384 + vdst[i_]) = V_[i_]; } while (0)
    if (NVL == 1) {
        FD_LOADK(kA, 0); FD_LOADV(vA, 0); FD_LOADK(kB, 1); FD_LOADV(vB, 1);
        *(u32x4*)(lds + 0 * 8192 + kdst) = kA; *(u32x4*)(lds + 32768 + 0 * 8192 + vdst[0]) = vA[0];
        *(u32x4*)(lds + 1 * 8192 + kdst) = kB; *(u32x4*)(lds + 32768 + 1 * 8192 + vdst[0]) = vB[0];
        FD_LOADK(kA, 2);
        *(u32x4*)(lds + 2 * 8192 + kdst) = kA;
    } else {
        FD_LOADK(kA, 0); FD_LOADV(vA, 0); FD_LOADK(kB, 1);
        FD_WRITEK(kA, 0); FD_WRITEV(vA, 0); FD_WRITEK(kB, 1);
        FD_LOADK(kA, 2); FD_LOADV(vA, 1);
    }
    __syncthreads();
    const int koff = r32 * 128;
    const int vlane = (4 * hi + ((lane & 15) >> 2)) * 64 + ((lane >> 4) & 1) * 32 + (lane & 3) * 8;
    f32x16 s0, s1;
    {
#pragma unroll
        for (int i = 0; i < 16; ++i) { s0[i] = 0.f; s1[i] = 0.f; }
        const char* Kb = lds + A_KOFF;
#pragma unroll
        for (int d0 = 0; d0 < 4; ++d0) {
            const int off = koff + (((2 * d0 + hi) ^ ((r32 >> 1) & 7)) << 4);
            const bf16x8 k0 = *(const bf16x8*)(Kb + off), k1 = *(const bf16x8*)(Kb + 4096 + off);
            s0 = MFMA32(k0, qf[d0], s0); s1 = MFMA32(k1, qf[d0], s1);
        }
    }
    __syncthreads();
    if (NVL == 1) {
#define FD4_WK(K_, j) do { *(u32x4*)(lds + (j) * 8192 + kdst) = K_; } while (0)
#define FD4_WV(V_, j) do { *(u32x4*)(lds + 32768 + (j) * 8192 + vdst[0]) = V_[0]; } while (0)
    for (int t = 0; t < NT; t += 4) {
        FD_LOADK(kA, t + 3); FD_LOADV(vA, t + 2); FD_LOADK(kB, t + 4); FD_LOADV(vB, t + 3);
        dense_step<DV, 1 * 8192, 32768 + 0 * 8192>(lds, qf, koff, vlane, r32, hi, sc, s0, s1, o, m_run, l_run);
        dense_step<DV, 2 * 8192, 32768 + 1 * 8192>(lds, qf, koff, vlane, r32, hi, sc, s0, s1, o, m_run, l_run);
        FD4_WK(kA, 3); FD4_WV(vA, 2); FD4_WK(kB, 0); FD4_WV(vB, 3);
        __syncthreads();
        FD_LOADK(kA, t + 5); FD_LOADV(vA, t + 4); FD_LOADK(kB, t + 6); FD_LOADV(vB, t + 5);
        dense_step<DV, 3 * 8192, 32768 + 2 * 8192>(lds, qf, koff, vlane, r32, hi, sc, s0, s1, o, m_run, l_run);
        dense_step<DV, 0 * 8192, 32768 + 3 * 8192>(lds, qf, koff, vlane, r32, hi, sc, s0, s1, o, m_run, l_run);
        FD4_WK(kA, 1); FD4_WV(vA, 0); FD4_WK(kB, 2); FD4_WV(vB, 1);
        __syncthreads();
    }
#undef FD4_WK
#undef FD4_WV
    } else {
    for (int t = 0; t < NT; t += 2) {
        dense_step<DV, A_KOFF + 8192, A_VOFF>(lds, qf, koff, vlane, r32, hi, sc, s0, s1, o, m_run, l_run);
        FD_WRITEK(kA, 0); FD_WRITEV(vA, 1);
        FD_LOADK(kA, t + 3); FD_LOADV(vA, t + 2);
        __syncthreads();
        dense_step<DV, A_KOFF, A_VOFF + 16384>(lds, qf, koff, vlane, r32, hi, sc, s0, s1, o, m_run, l_run);
        FD_WRITEK(kA, 1); FD_WRITEV(vA, 0);
        FD_LOADK(kA, t + 4); FD_LOADV(vA, t + 3);
        __syncthreads();
    }
    }
#undef FD_LOADK
#undef FD_LOADV
#undef FD_WRITEK
#undef FD_WRITEV
    __builtin_amdgcn_s_setprio(0);
    l_tot = l_run + __shfl_xor(l_run, 32);
}

__device__ __forceinline__ void store_o64(const f32x16 (&o)[2], float inv, bf16_t* orow  , int hi) {
#pragma unroll
    for (int db = 0; db < 2; ++db)
#pragma unroll
        for (int g = 0; g < 4; ++g) {
            u32x2 w; w.x = pk2(o[db][4 * g] * inv, o[db][4 * g + 1] * inv); w.y = pk2(o[db][4 * g + 2] * inv, o[db][4 * g + 3] * inv);
            *(u32x2*)(orow + 32 * db + 8 * g + 4 * hi) = w;
        }
}

__device__ __forceinline__ void seq_of_unit(int v, int& b, int& h, int& qb, int& T, int& rowbase) {
    if (v < 2048) { qb = v & 15; h = (v >> 4) & 7; b = v >> 7; T = 4096; rowbase = MP + b * 4096; }
    else { const int x = v - 2048; qb = x & 7; h = (x >> 3) & 7; b = x >> 6; T = 2048; rowbase = b * 2048; }
}

#define XB_TMO      128
#define XB_XCNT(j)  (256  + 64 * (j))
#define XB_XSUB(j)  (1280 + 64 * (j))
#define XB_XGEN(j)  (2304 + 64 * (j))
#define XB_TOP      3328
#define XB_TOPGEN   3392
#define XCD_BAR_WORDS 3456
#define XB_SPIN_CAP (1u << 18)

__device__ __forceinline__ unsigned xb_ld(unsigned* p)              { return __hip_atomic_load(p, __ATOMIC_RELAXED, __HIP_MEMORY_SCOPE_AGENT); }
__device__ __forceinline__ unsigned xb_add(unsigned* p, unsigned v) { return __hip_atomic_fetch_add(p, v, __ATOMIC_RELAXED, __HIP_MEMORY_SCOPE_AGENT); }
__device__ __forceinline__ unsigned xb_xcc_id() { return (unsigned)__builtin_amdgcn_s_getreg((3 << 11) | 20) & 0xFu; }
#define XB_SPIN(cond, bar) do { unsigned _sp = 0; while (cond) { __builtin_amdgcn_s_sleep(1); \
    if ((++_sp & 255u) == 0u) { if (xb_ld(&(bar)[XB_TMO])) break; if (_sp > XB_SPIN_CAP) { atomicAdd(&(bar)[XB_TMO], 1u); break; } } } } while (0)

struct XcdBarrier {
    unsigned* bar; unsigned x;
    volatile LAS unsigned* st;
};

__device__ __forceinline__ XcdBarrier xcd_barrier_post(unsigned* bar, volatile LAS unsigned* st) {
    XcdBarrier b; b.bar = bar; b.x = xb_xcc_id(); b.st = st;
    if (threadIdx.x == 0) (void)xb_add(&bar[XB_XCNT(b.x)], 1u);
    return b;
}
__device__ __forceinline__ void xcd_barrier_complete(unsigned* bar, unsigned x, unsigned& nloc, unsigned& nx) {
    const unsigned G = gridDim.x * gridDim.y * gridDim.z;
    unsigned sum, cnt, mine, sp = 0u;
    for (;;) {
        sum = 0u; cnt = 0u; mine = 0u;
#pragma unroll
        for (unsigned j = 0; j < 16; ++j) { const unsigned c = xb_ld(&bar[XB_XCNT(j)]); sum += c; cnt += (c > 0u) ? 1u : 0u; mine = (j == x) ? c : mine; }
        if (sum == G) break;
        __builtin_amdgcn_s_sleep(1);
        if ((++sp & 255u) == 0u) { if (xb_ld(&bar[XB_TMO])) break; if (sp > XB_SPIN_CAP) { atomicAdd(&bar[XB_TMO], 1u); break; } }
    }
    nloc = mine > 0u ? mine : 1u; nx = cnt > 0u ? cnt : 1u;
}

__device__ __forceinline__ void xcd_barrier(const XcdBarrier& b) {
    asm volatile("s_waitcnt vmcnt(0)" ::: "memory");
    __syncthreads();
    if (threadIdx.x == 0) {
        unsigned* bar = b.bar;
        __builtin_amdgcn_s_waitcnt(0);
        unsigned nloc = b.st[0], nx = b.st[1];
        if (nloc == 0u) { xcd_barrier_complete(bar, b.x, nloc, nx); b.st[0] = nloc; b.st[1] = nx; }
        const unsigned old = xb_add(&bar[XB_XSUB(b.x)], 1u);
        const unsigned gen = old / nloc;
        if (old + 1u == (gen + 1u) * nloc) {
            __builtin_amdgcn_fence(__ATOMIC_RELEASE, "agent");
            asm volatile("s_waitcnt vmcnt(0)" ::: "memory");
            const unsigned og = xb_add(&bar[XB_TOP], 1u);
            const unsigned tg = og / nx;
            if (og + 1u == (tg + 1u) * nx) xb_add(&bar[XB_TOPGEN], 1u);
            else XB_SPIN(xb_ld(&bar[XB_TOPGEN]) == tg, bar);
            __builtin_amdgcn_fence(__ATOMIC_ACQUIRE, "agent");
            xb_add(&bar[XB_XGEN(b.x)], 1u);
            asm volatile("s_waitcnt vmcnt(0)" ::: "memory");
        } else {
            XB_SPIN(xb_ld(&bar[XB_XGEN(b.x)]) == gen, bar);
            __builtin_amdgcn_fence(__ATOMIC_ACQUIRE, "agent");
            asm volatile("s_waitcnt vmcnt(0)" ::: "memory");
        }
    }
    __syncthreads();
}

struct Ctx {
    Params P; char* lds; int tid, lane, wave, G, bid, gw, NGW, vcu;
    float* X; bf16_t *Hb, *PROJ, *ATT, *HID, *WinE, *WoutE, *WinO, *WoutO, *Wup, *Wdn; float *ropeC, *ropeS, *axC, *axS, *rss;
};
__device__ __forceinline__ void ctx_init(Ctx& C, const Params& P, char* lds) {
    C.P = P; C.lds = lds; C.tid = threadIdx.x; C.lane = C.tid & 63; C.wave = __builtin_amdgcn_readfirstlane(C.tid >> 6);
    C.G = gridDim.x; C.bid = blockIdx.x; C.vcu = (C.G % 8 == 0) ? (C.bid % 8) * (C.G / 8) + C.bid / 8 : C.bid; C.gw = C.bid * NWAVES + C.wave; C.NGW = C.G * NWAVES;
    unsigned char* ws = P.ws; C.X = P.out;
    C.Hb = (bf16_t*)(ws + WS_H); C.PROJ = (bf16_t*)(ws + WS_PROJ); C.ATT = (bf16_t*)(ws + WS_ATT); C.HID = (bf16_t*)(ws + WS_HID);
    C.WinE = (bf16_t*)(ws + WS_WINE); C.WoutE = (bf16_t*)(ws + WS_WOUTE); C.WinO = (bf16_t*)(ws + WS_WINO); C.WoutO = (bf16_t*)(ws + WS_WOUTO);
    C.Wup = (bf16_t*)(ws + WS_WUP); C.Wdn = (bf16_t*)(ws + WS_WDN);
    C.ropeC = (float*)(ws + WS_ROPE_C); C.ropeS = (float*)(ws + WS_ROPE_S); C.axC = (float*)(ws + WS_AX_C); C.axS = (float*)(ws + WS_AX_S); C.rss = (float*)(ws + WS_RSS);
}

__device__ __forceinline__ void ph_prologue(const Ctx& C) {
    const Params& P = C.P; const int lane = C.lane;
    float* scr = (float*)(C.lds + C.wave * 16384);
    constexpr int I_INE = 16 * (NE / 32), I_SQ = 16 * 32, I_UP = 16 * (FF / 32), I_DN = 64 * 32;
    constexpr int NITEMS = I_INE + I_SQ + I_UP + I_DN;
    for (int it = C.gw; it < NITEMS; it += C.NGW) {
        int r = it;
        if (r < I_INE) { transpose_item(P.in[3], DM, NE, C.WinE, scr, r, lane, 0, P.in[2]); continue; } r -= I_INE;
        if (r < I_SQ) { transpose_item(P.in[7], DM, DM, C.WoutE, scr, r, lane, -1, nullptr); continue; } r -= I_SQ;
        if (r < I_UP) { transpose_item(P.in[17], DM, FF, C.Wup, scr, r, lane, -1, P.in[16]); continue; } r -= I_UP;
        transpose_item(P.in[18], FF, DM, C.Wdn, scr, r, lane, -1, nullptr);
    }
    for (int idx = C.bid * NTHREADS + C.tid; idx < 4096 * 32; idx += C.G * NTHREADS) {
        const int t = idx >> 5, i = idx & 31;
        const float inv = exp2f(-(float)(2 * i) * (1.f / 64.f) * 13.287712379549449f);
        float c, s; cs_of((float)t * inv, c, s); C.ropeC[idx] = c; C.ropeS[idx] = s;
    }
    for (int idx = C.bid * NTHREADS + C.tid; idx < 64 * 16; idx += C.G * NTHREADS) {
        const int p = idx >> 4, i = idx & 15;
        const float inv = exp2f(-(float)(2 * i) * (1.f / 32.f) * 13.287712379549449f);
        float c, s; cs_of((float)p * inv, c, s); C.axC[idx] = c; C.axS[idx] = s;
    }
    for (int m = C.gw; m < MT; m += 2 * C.NGW) {
        const int m2 = m + C.NGW;
        const float* src = (m < MP) ? P.in[0] + (size_t)m * DM : P.in[1] + (size_t)(m - MP) * DM;
        if (m2 < MT) {
            const float* src2 = (m2 < MP) ? P.in[0] + (size_t)m2 * DM : P.in[1] + (size_t)(m2 - MP) * DM;
            cvt_row_bf16_x2(src, src2, C.Hb + (size_t)m * DM, C.Hb + (size_t)m2 * DM, C.rss + (size_t)m * 16, C.rss + (size_t)m2 * 16, lane);
        } else cvt_row_bf16(src, C.Hb + (size_t)m * DM, C.rss + (size_t)m * 16, lane);
    }
}
__device__ __forceinline__ void ph_weights_late(const Ctx& C, int first) {
    const Params& P = C.P; const int lane = C.lane;
    float* scr = (float*)(C.lds + C.wave * 16384);
    constexpr int I_SQ = 16 * 32, I_INO = 16 * (NO / 32), I_UP = 16 * (FF / 32), I_DN = 64 * 32;
    constexpr int NITEMS = I_INO + I_SQ + I_UP + I_DN;
    const int nw = (C.G - first) * NWAVES;
    for (int it = (C.bid - first) * NWAVES + C.wave; it < NITEMS; it += nw) {
        int r = it;
        if (r < I_INO) { transpose_item(P.in[9], DM, NO, C.WinO, scr, r, lane, 1, P.in[8]); continue; } r -= I_INO;
        if (r < I_SQ) { transpose_item(P.in[15], DM, DM, C.WoutO, scr, r, lane, -1, nullptr); continue; } r -= I_SQ;
        if (r < I_UP) { transpose_item(P.in[17] + (size_t)DM * FF, DM, FF, C.Wup + (size_t)DM * FF, scr, r, lane, -1, P.in[16] + DM); continue; } r -= I_UP;
        transpose_item(P.in[18] + (size_t)DM * FF, FF, DM, C.Wdn + (size_t)DM * FF, scr, r, lane, -1, nullptr);
    }
}
template <class Epi>
__device__ __forceinline__ void ph_gemm(const Ctx& C, const bf16_t* A, const bf16_t* Bt, int N, int K, const Epi& E) {
    pg8::Gemm g{A, Bt, MT, N, K}; pg8::StaticOrder S; S.init(MT, N, C.G, C.bid);
    pg8::gemm_phase<Epi, pg8::StaticOrder, PG8_ALIGN, PG8_SP2>((PG8_LAS unsigned char*)C.lds, g, S, E);
}
__device__ __forceinline__ void ph_norm(const Ctx& C, const float* g) {
    for (int m = C.gw; m < MT; m += C.NGW) rms_row_bf16(C.X + (size_t)m * DM, g, C.Hb + (size_t)m * DM, nullptr, C.lane);
}
__device__ __forceinline__ void ph_final(const Ctx& C) {
    for (int m = C.gw; m < MT; m += 2 * C.NGW) {
        const int m2 = m + C.NGW;
        if (m2 < MT) final_row_x2(C.Hb + (size_t)m * DM, C.Hb + (size_t)m2 * DM, pg8::row_rstd(C.rss + (size_t)4 * RS, m), pg8::row_rstd(C.rss + (size_t)4 * RS, m2), C.P.in[19], C.X + (size_t)m * DM, C.X + (size_t)m2 * DM, C.lane);
        else final_row(C.Hb + (size_t)m * DM, pg8::row_rstd(C.rss + (size_t)4 * RS, m), C.P.in[19], C.X + (size_t)m * DM, C.lane);
    }
}
__device__ __forceinline__ void ph_qk_axial(const Ctx& C) {
    const int lane = C.lane, hs = lane >> 5, p = lane & 31;
    const int dlo = (p < 16) ? p : (16 + p), dhi = dlo + 16, fi = p & 15;
    const float* gq = C.P.in[5]; const float* gk = C.P.in[6];
    const float gq_lo = gq[dlo], gq_hi = gq[dhi], gk_lo = gk[dlo], gk_hi = gk[dhi];
    for (int m = C.gw; m < MT; m += C.NGW) {
        const int t = (m < MP) ? (m & 2047) : ((m - MP) & 4095);
        const int pos = (p < 16) ? (t >> 6) : (t & 63);
        const float c = C.axC[pos * 16 + fi], s = C.axS[pos * 16 + fi];
        bf16_t* row = C.PROJ + (size_t)m * NE;
#pragma unroll
        for (int it = 0; it < 5; ++it) {
            const int j = 2 * it + hs;
            bf16_t* hp = row + ((j < 8) ? (1536 + 64 * j) : (2048 + 64 * (j - 8)));
            const float a = bf2f(hp[dlo]), b = bf2f(hp[dhi]);
            float ss = a * a + b * b;
            ss += __shfl_xor(ss, 1); ss += __shfl_xor(ss, 2); ss += __shfl_xor(ss, 4); ss += __shfl_xor(ss, 8); ss += __shfl_xor(ss, 16);
            const float rstd = 1.0f / sqrtf(ss * (1.f / 64.f) + 1e-6f);
            const float an = a * rstd * ((j < 8) ? gq_lo : gk_lo), bn = b * rstd * ((j < 8) ? gq_hi : gk_hi);
            hp[dlo] = f2bf(an * c - bn * s); hp[dhi] = f2bf(bn * c + an * s);
        }
    }
}
__device__ __forceinline__ void ph_rope_odd(const Ctx& C) {
    const int lane = C.lane, hs = lane >> 5, p = lane & 31;
    for (int m = C.gw; m < MT; m += C.NGW) {
        const int t = (m < MP) ? (m & 2047) : ((m - MP) & 4095);
        const float c = C.ropeC[t * 32 + p], s = C.ropeS[t * 32 + p];
        bf16_t* row = C.PROJ + (size_t)m * NO;
#pragma unroll 4
        for (int it = 0; it < 16; ++it) {
            bf16_t* hp = row + 64 * (2 * it + hs);
            const float a = bf2f(hp[p]), b = bf2f(hp[p + 32]);
            hp[p] = f2bf(a * c - b * s); hp[p + 32] = f2bf(b * c + a * s);
        }
    }
}
__device__ __forceinline__ void ph_attn_gqa(const Ctx& C) {
    const float sc = 0.125f * LOG2E;
    const int lane = C.lane, wave = C.wave, r32 = lane & 31, hi = lane >> 5;
    for (int u = C.vcu; u < 2560; u += C.G) {
        int b, h, qb, T, rowbase; seq_of_unit(u, b, h, qb, T, rowbase);
        const size_t qrow0 = (size_t)rowbase + qb * 256 + wave * 32;
        const bf16_t* Qw = C.PROJ + qrow0 * NE + 1536 + 64 * h;
        const bf16_t* Kh = C.PROJ + (size_t)rowbase * NE + 2048 + 64 * (h >> 2);
        const bf16_t* Vh = C.PROJ + (size_t)rowbase * NE + 2176 + 64 * (h >> 2);
        f32x16 o[2]; float l;
        flash_pass_dense<64>(C.lds, Qw, Kh, Vh, NE, T / 64, sc, o, l);
        store_o64(o, 1.0f / l, C.ATT + (qrow0 + r32) * DM + 512 + 64 * h, hi);
    }
}
__device__ __forceinline__ void ph_attn_na(const Ctx& C) {
    const float sc = 0.125f * LOG2E;
    const int lane = C.lane, wave = C.wave, r32 = lane & 31, hi = lane >> 5;
    for (int u = C.vcu; u < 2560; u += C.G) {
        int b, h, qb, T, rowbase; seq_of_unit(u, b, h, qb, T, rowbase);
        const int rows = T / 64, R0 = qb * 4, r = R0 + (wave >> 1);
        const int tb = min(max(R0 - 4, 0), rows - 8), te = min(max(R0 + 3 - 4, 0), rows - 8) + 8;
        const int wb = min(max(r - 4, 0), rows - 8), we = wb + 8;
        for (int i = C.tid; i < 465; i += NTHREADS) ((float*)(C.lds + A_RPB))[i] = C.P.in[4][h * 465 + i] * LOG2E;
        const size_t qrow0 = (size_t)rowbase + qb * 256 + wave * 32;
        const bf16_t* Qw = C.PROJ + qrow0 * NE + 64 * h;
        const bf16_t* Kh = C.PROJ + (size_t)rowbase * NE + 512 + 64 * h;
        const bf16_t* Vh = C.PROJ + (size_t)rowbase * NE + 1024 + 64 * h;
        f32x16 o[2]; float l;
        flash_pass<64, true>(C.lds, Qw, Kh, Vh, NE, tb, te, wb, we, sc, 32 * (wave & 1), r, o, l);
        store_o64(o, 1.0f / l, C.ATT + (qrow0 + r32) * DM + 64 * h, hi);
    }
}
__device__ __forceinline__ void ph_diff(const Ctx& C) {
    const float sc = 0.125f * LOG2E;
    const int lane = C.lane, wave = C.wave, r32 = lane & 31, hi = lane >> 5;
    const float lam_init = 0.8f - 0.6f * 0.7408182206817179f;
    const float s1 = wave_sum(C.P.in[10][lane] * C.P.in[11][lane]), s2 = wave_sum(C.P.in[12][lane] * C.P.in[13][lane]);
    const float lam = __expf(s1) - __expf(s2) + lam_init;
    for (int u = C.vcu; u < 2560; u += C.G) {
        int b, h, qb, T, rowbase; seq_of_unit(u, b, h, qb, T, rowbase);
        const size_t qrow0 = (size_t)rowbase + qb * 256 + wave * 32;
        const bf16_t* Vh = C.PROJ + (size_t)rowbase * NO + 2048 + 128 * h;
        unsigned* stash = (unsigned*)(C.lds + A_STASH + wave * 8192) + lane;
        {
            f32x16 o[4]; float l;
            flash_pass_dense<128>(C.lds, C.PROJ + qrow0 * NO + 64 * (2 * h), C.PROJ + (size_t)rowbase * NO + 1024 + 64 * (2 * h), Vh, NO, T / 64, sc, o, l);
            const float inv = 1.0f / l;
#pragma unroll
            for (int db = 0; db < 4; ++db)
#pragma unroll
                for (int j = 0; j < 8; ++j) stash[(db * 8 + j) * 64] = pk2(o[db][2 * j] * inv, o[db][2 * j + 1] * inv);
        }
        f32x16 o[4]; float l;
        flash_pass_dense<128>(C.lds, C.PROJ + qrow0 * NO + 64 * (2 * h + 1), C.PROJ + (size_t)rowbase * NO + 1024 + 64 * (2 * h + 1), Vh, NO, T / 64, sc, o, l);
        const float inv = lam / l;
        float ss = 0.f;
#pragma unroll
        for (int db = 0; db < 4; ++db)
#pragma unroll
            for (int j = 0; j < 8; ++j) {
                const unsigned pk = stash[(db * 8 + j) * 64];
                const float a = bf_lo(pk) - o[db][2 * j] * inv, c = bf_hi(pk) - o[db][2 * j + 1] * inv;
                o[db][2 * j] = a; o[db][2 * j + 1] = c; ss += a * a + c * c;
            }
        ss += __shfl_xor(ss, 32);
        const float rstd = (1.0f - lam_init) / sqrtf(ss * (1.f / 128.f) + 1e-5f);
        bf16_t* orow = C.ATT + (qrow0 + r32) * DM + 128 * h;
#pragma unroll
        for (int db = 0; db < 4; ++db)
#pragma unroll
            for (int g = 0; g < 4; ++g) {
                const int d = 32 * db + 8 * g + 4 * hi;
                const f32x4 gg = *(const f32x4*)(C.P.in[14] + d);
                u32x2 w; w.x = pk2(o[db][4 * g] * rstd * gg.x, o[db][4 * g + 1] * rstd * gg.y); w.y = pk2(o[db][4 * g + 2] * rstd * gg.z, o[db][4 * g + 3] * rstd * gg.w);
                *(u32x2*)(orow + d) = w;
            }
    }
}
__global__ void __launch_bounds__(NTHREADS) fwd_megakernel(Params P) {
    extern __shared__ __attribute__((aligned(16))) unsigned char lds_raw[];
    cg::grid_group grid = cg::this_grid();
    Ctx C; ctx_init(C, P, (char*)lds_raw);
    volatile LAS unsigned* bst = (volatile LAS unsigned*)((LAS unsigned char*)lds_raw + 140 * 1024);
    if (threadIdx.x == 0) { bst[0] = 0u; bst[1] = 0u; }
    __syncthreads();
    const XcdBarrier bar = xcd_barrier_post((unsigned*)(P.ws + WS_BAR), bst);
    ph_prologue(C);
    if (P.ws == nullptr) grid.sync();
    xcd_barrier(bar);
    ph_gemm(C, C.Hb, C.WinE, NE, DM, pg8::EpiProj<0>{C.PROJ, NE, C.axC, C.axS, P.in[5], P.in[6], MP, C.rss});
    if (C.G == 256 && C.bid >= 64) ph_weights_late(C, 64);
    else if (C.G != 256) ph_weights_late(C, 0);
    xcd_barrier(bar);
    ph_attn_gqa(C);
    ph_attn_na(C);
    xcd_barrier(bar);
    ph_gemm(C, C.ATT, C.WoutE, DM, DM, pg8::EpiResid{nullptr, nullptr, MP, DM, C.Hb, C.rss + RS});
    xcd_barrier(bar);
    ph_gemm(C, C.Hb, C.Wup, FF, DM, pg8::EpiBf16<2>{C.HID, FF, C.rss + RS});
    xcd_barrier(bar);
    ph_gemm(C, C.HID, C.Wdn, DM, FF, pg8::EpiResid{nullptr, nullptr, MP, DM, C.Hb, C.rss + 2 * RS});
    xcd_barrier(bar);
    ph_gemm(C, C.Hb, C.WinO, NO, DM, pg8::EpiProj<1>{C.PROJ, NO, C.ropeC, C.ropeS, nullptr, nullptr, MP, C.rss + 2 * RS});
    xcd_barrier(bar);
    ph_diff(C);
    xcd_barrier(bar);
    ph_gemm(C, C.ATT, C.WoutO, DM, DM, pg8::EpiResid{nullptr, nullptr, MP, DM, C.Hb, C.rss + 3 * RS});
    xcd_barrier(bar);
    ph_gemm(C, C.Hb, C.Wup + (size_t)DM * FF, FF, DM, pg8::EpiBf16<2>{C.HID, FF, C.rss + 3 * RS});
    xcd_barrier(bar);
    ph_gemm(C, C.HID, C.Wdn + (size_t)DM * FF, DM, FF, pg8::EpiResid{nullptr, nullptr, MP, DM, C.Hb, C.rss + 4 * RS});
    xcd_barrier(bar);
    ph_final(C);
}

extern "C" void kernel_launch(void* const* d_in, const int* in_sizes, int n_in, void* d_out, int out_size, void* d_ws, size_t ws_size, hipStream_t stream) {
    static int grid = 0;
    if (grid == 0) {
        if (n_in != 20 || out_size != MT * DM || ws_size < WS_END) { fprintf(stderr, "kernel_launch: unexpected shapes (n_in %d out %d ws %zu)\n", n_in, out_size, ws_size); grid = -1; return; }
        int dev = 0, cus = 0, per_cu = 0;
        hipGetDevice(&dev);
        hipDeviceGetAttribute(&cus, hipDeviceAttributeMultiprocessorCount, dev);
        if (hipFuncSetAttribute((const void*)fwd_megakernel, hipFuncAttributeMaxDynamicSharedMemorySize, LDS_BYTES) != hipSuccess) { fprintf(stderr, "kernel_launch: hipFuncSetAttribute failed\n"); }
        if (hipOccupancyMaxActiveBlocksPerMultiprocessor(&per_cu, (const void*)fwd_megakernel, NTHREADS, LDS_BYTES) != hipSuccess || per_cu < 1) { fprintf(stderr, "kernel_launch: occupancy query gave %d\n", per_cu); per_cu = 1; }
        (void)hipGetLastError();
        grid = cus * per_cu;
    }
    if (grid < 0) return;
    if (hipMemsetAsync((char*)d_ws + WS_BAR, 0, BAR_BYTES, stream) != hipSuccess) { fprintf(stderr, "kernel_launch: memset of the barrier words failed\n"); return; }
    Params p{};
    for (int i = 0; i < 20; ++i) p.in[i] = (const float*)d_in[i];
    p.out = (float*)d_out; p.ws = (unsigned char*)d_ws;
    void* args[] = {&p};
    hipError_t e = hipLaunchCooperativeKernel((const void*)fwd_megakernel, dim3(grid), dim3(NTHREADS), args, LDS_BYTES, stream);
    if (e != hipSuccess) fprintf(stderr, "cooperative launch failed: %s (grid %d)\n", hipGetErrorString(e), grid);
}
```

```cpp
#include <hip/hip_runtime.h>
#include <hip/hip_cooperative_groups.h>
#include <cstdio>
#include <cstdint>
namespace cg = cooperative_groups;
namespace pg8 {
#define PG8_LAS __attribute__((address_space(3)))
typedef unsigned short bf16_t;
typedef short bf16x8 __attribute__((ext_vector_type(8)));
typedef float f32x4 __attribute__((ext_vector_type(4)));
typedef unsigned u32x4 __attribute__((ext_vector_type(4)));
constexpr int BM = 256, BK = 64, HALF = 128, HTB = HALF * BK * 2  , STAGE_BYTES = 8 * HTB, NXCD = 8, WGM = 8;

__host__ __device__ __forceinline__ int lds_byte(int r, int c) { const int st = (r >> 4) * 2 + (c >> 5), rr = r & 15, cc = c & 31, ob = rr * 64 + cc * 2; return st * 1024 + (ob ^ (((ob >> 9) & 1) << 5)); }
__host__ __device__ __forceinline__ void stage_rc(int b, int& R, int& C) { const int st = b / 1024, sb = b % 1024, swz = sb ^ (((sb >> 9) & 1) << 5); R = (st >> 1) * 16 + swz / 64; C = (st & 1) * 32 + (swz % 64) / 2; }
__host__ __device__ __forceinline__ int perm32(int rho) { const int n = rho >> 4, i = rho & 15; return 8 * (i >> 2) + 4 * n + (i & 3); }

struct Unit { int pm, pn; };
struct Gemm { const bf16_t* A; const bf16_t* Bt; int M, N, K; };

struct StaticOrder {
    int nM, nN, nwg, G, c;
    __host__ __device__ void init(int M, int N, int G_, int c_) { nM = M / BM; nN = N / BM; nwg = nM * nN; G = G_; c = c_; }
    __host__ __device__ bool next(int i, Unit& u) const {
        const long L = (long)i * G + c; if (L >= nwg) return false;
        int wgid = (int)L; { const int q = nwg / NXCD, r = nwg % NXCD, xcd = wgid % NXCD, off = wgid / NXCD; wgid = (xcd < r ? xcd * (q + 1) : r * (q + 1) + (xcd - r) * q) + off; }
        const int nig = WGM * nN, gid = wgid / nig, fm = gid * WGM, gsz = (nM - fm) < WGM ? (nM - fm) : WGM;
        u.pm = fm + ((wgid % nig) % gsz); u.pn = (wgid % nig) / gsz; return true;
    }
    __device__ __forceinline__ void a_ready(const Unit&) const {}
    __device__ __forceinline__ void done(const Unit&) const {}
};

typedef float f32x2_t __attribute__((ext_vector_type(2))); typedef __bf16 bf16x2_t __attribute__((ext_vector_type(2)));
__device__ __forceinline__ unsigned cvt_pk_bf16(float lo, float hi) { f32x2_t v = {lo, hi}; bf16x2_t b = __builtin_convertvector(v, bf16x2_t); return __builtin_bit_cast(unsigned, b); }
__device__ __forceinline__ float row_rstd(const float* rssp, int row) {
    const f32x4* p = (const f32x4*)(rssp + (size_t)row * 16);
    const f32x4 a = p[0], b = p[1], c = p[2], d = p[3];
    const float s = ((a[0] + a[1]) + (a[2] + a[3])) + ((b[0] + b[1]) + (b[2] + b[3])) + (((c[0] + c[1]) + (c[2] + c[3])) + ((d[0] + d[1]) + (d[2] + d[3])));
    return 1.0f / sqrtf(s * (1.f / 1024.f) + 1e-6f);
}
__device__ __forceinline__ float row_rstd_q(const float* rssp, int row, int fq) {
    const f32x4 a = *(const f32x4*)(rssp + (size_t)row * 16 + 4 * fq);
    float q = (a[0] + a[1]) + (a[2] + a[3]);
    q += __shfl_xor(q, 16); q += __shfl_xor(q, 32);
    return __builtin_amdgcn_rsqf(q * (1.f / 1024.f) + 1e-6f);
}
template <int ACT  > struct EpiBf16 {
    static constexpr bool PERM = true, AFTER_DRAIN = false;
    bf16_t* O; int ldc; const float* rss;
    __device__ __forceinline__ void operator()(const f32x4 (&acc)[2][2][4][2], const Unit& u, int wr, int wc, int fr, int fq) const {
        const int row0 = u.pm * BM + wr * 64 + fr; const int col0 = u.pn * BM + wc * 32 + 8 * fq;
#pragma unroll
        for (int ai = 0; ai < 2; ++ai)
#pragma unroll
            for (int m = 0; m < 4; ++m) { bf16_t* rowp = O + (size_t)(row0 + ai * HALF + m * 16) * ldc + col0;
                const float rstd = row_rstd_q(rss, row0 + ai * HALF + m * 16, fq);
#pragma unroll
                for (int bj = 0; bj < 2; ++bj) { f32x4 v0 = acc[ai][bj][m][0] * rstd, v1 = acc[ai][bj][m][1] * rstd;
                    if (ACT == 2) {
#pragma unroll
                        for (int e = 0; e < 4; ++e) { float a = fmaxf(v0[e], 0.f), b = fmaxf(v1[e], 0.f); v0[e] = a * a; v1[e] = b * b; } }
                    u32x4 w; w.x = cvt_pk_bf16(v0[0], v0[1]); w.y = cvt_pk_bf16(v0[2], v0[3]); w.z = cvt_pk_bf16(v1[0], v1[1]); w.w = cvt_pk_bf16(v1[2], v1[3]);
                    *(u32x4*)(rowp + bj * HALF) = w; } }
    }
};
__host__ __device__ __forceinline__ int proj_phys_to_log(int mode, int n) {
    const int pn = n >> 8, c = n & 255, bj = c >> 7, wc = (c >> 5) & 3, fq = (c >> 3) & 3, e = c & 7;
    const bool axial = (mode == 0) && (pn == 6 || pn == 7 || (pn == 8 && wc < 2));
    const int inner = axial ? ((e < 4) ? 4 * fq + e : 16 + 4 * fq + (e - 4)) : 8 * fq + e;
    return pn * 256 + 64 * wc + 32 * bj + inner;
}
template <int MODE> struct EpiProj {
    static constexpr bool PERM = true, AFTER_DRAIN = false;
    bf16_t* O; int ldc; const float* tabC; const float* tabS; const float* gq; const float* gk; int split; const float* rss;
    __device__ __forceinline__ void operator()(const f32x4 (&acc)[2][2][4][2], const Unit& u, int wr, int wc, int fr, int fq) const {
        const int row0 = u.pm * BM + wr * 64 + fr;
        const int cbase = u.pn * BM + 64 * wc;
        const bool special = (MODE == 1) ? (u.pn < 8) : (u.pn == 6 || u.pn == 7 || (u.pn == 8 && wc < 2));
        const int tmask = (u.pm * BM < split) ? 2047 : 4095;
        if (!special) {
#pragma unroll
            for (int ai = 0; ai < 2; ++ai)
#pragma unroll
                for (int m = 0; m < 4; ++m) { bf16_t* rowp = O + (size_t)(row0 + ai * HALF + m * 16) * ldc + cbase + 8 * fq;
                    const float rs_ = row_rstd_q(rss, row0 + ai * HALF + m * 16, fq);
#pragma unroll
                    for (int bj = 0; bj < 2; ++bj) { const f32x4 v0 = acc[ai][bj][m][0] * rs_, v1 = acc[ai][bj][m][1] * rs_;
                        u32x4 w; w.x = cvt_pk_bf16(v0[0], v0[1]); w.y = cvt_pk_bf16(v0[2], v0[3]); w.z = cvt_pk_bf16(v1[0], v1[1]); w.w = cvt_pk_bf16(v1[2], v1[3]);
                        *(u32x4*)(rowp + 32 * bj) = w; } }
        } else if (MODE == 1) {
#pragma unroll
            for (int ai = 0; ai < 2; ++ai)
#pragma unroll
                for (int m = 0; m < 4; ++m) { const int row = row0 + ai * HALF + m * 16; const int t = row & tmask;
                    const f32x4 c0 = *(const f32x4*)(tabC + t * 32 + 8 * fq), c1 = *(const f32x4*)(tabC + t * 32 + 8 * fq + 4);
                    const f32x4 s0 = *(const f32x4*)(tabS + t * 32 + 8 * fq), s1 = *(const f32x4*)(tabS + t * 32 + 8 * fq + 4);
                    const float rs_ = row_rstd_q(rss, row, fq);
                    const f32x4 a0 = acc[ai][0][m][0] * rs_, a1 = acc[ai][0][m][1] * rs_, b0 = acc[ai][1][m][0] * rs_, b1 = acc[ai][1][m][1] * rs_;
                    const f32x4 x0 = a0 * c0 - b0 * s0, x1 = a1 * c1 - b1 * s1, y0 = b0 * c0 + a0 * s0, y1 = b1 * c1 + a1 * s1;
                    bf16_t* rowp = O + (size_t)row * ldc + cbase + 8 * fq;
                    u32x4 w; w.x = cvt_pk_bf16(x0[0], x0[1]); w.y = cvt_pk_bf16(x0[2], x0[3]); w.z = cvt_pk_bf16(x1[0], x1[1]); w.w = cvt_pk_bf16(x1[2], x1[3]);
                    *(u32x4*)(rowp) = w;
                    w.x = cvt_pk_bf16(y0[0], y0[1]); w.y = cvt_pk_bf16(y0[2], y0[3]); w.z = cvt_pk_bf16(y1[0], y1[1]); w.w = cvt_pk_bf16(y1[2], y1[3]);
                    *(u32x4*)(rowp + 32) = w; }
        } else {
            const float* g = (u.pn == 8) ? gk : gq;
            f32x4 gl[2], gh[2];
#pragma unroll
            for (int bj = 0; bj < 2; ++bj) { gl[bj] = *(const f32x4*)(g + 32 * bj + 4 * fq); gh[bj] = *(const f32x4*)(g + 32 * bj + 16 + 4 * fq); }
#pragma unroll
            for (int ai = 0; ai < 2; ++ai)
#pragma unroll
                for (int m = 0; m < 4; ++m) { const int row = row0 + ai * HALF + m * 16; const int t = row & tmask;
                    const float rs_ = row_rstd_q(rss, row, fq);
                    float ss = 0.f;
#pragma unroll
                    for (int bj = 0; bj < 2; ++bj)
#pragma unroll
                        for (int n = 0; n < 2; ++n) { const f32x4 v = acc[ai][bj][m][n] * rs_; ss += (v[0] * v[0] + v[1] * v[1]) + (v[2] * v[2] + v[3] * v[3]); }
                    ss += __shfl_xor(ss, 16); ss += __shfl_xor(ss, 32);
                    const float rstd = rs_ * __builtin_amdgcn_rsqf(ss * (1.f / 64.f) + 1e-6f);
                    bf16_t* rowp = O + (size_t)row * ldc + cbase + 4 * fq;
#pragma unroll
                    for (int bj = 0; bj < 2; ++bj) { const int pos = (bj == 0) ? (t >> 6) : (t & 63);
                        const f32x4 c = *(const f32x4*)(tabC + pos * 16 + 4 * fq), s = *(const f32x4*)(tabS + pos * 16 + 4 * fq);
                        const f32x4 a = acc[ai][bj][m][0] * rstd * gl[bj], b = acc[ai][bj][m][1] * rstd * gh[bj];
                        const f32x4 x = a * c - b * s, y = b * c + a * s;
                        typedef unsigned u32x2_t __attribute__((ext_vector_type(2)));
                        u32x2_t w; w.x = cvt_pk_bf16(x[0], x[1]); w.y = cvt_pk_bf16(x[2], x[3]); *(u32x2_t*)(rowp + 32 * bj) = w;
                        w.x = cvt_pk_bf16(y[0], y[1]); w.y = cvt_pk_bf16(y[2], y[3]); *(u32x2_t*)(rowp + 32 * bj + 16) = w; } }
        }
    }
};
struct EpiResid {
    static constexpr bool PERM = true, AFTER_DRAIN = false;
    const float* B0; const float* B1; int split; int ldc; bf16_t* H; float* rss;
    __device__ __forceinline__ void operator()(const f32x4 (&acc)[2][2][4][2], const Unit& u, int wr, int wc, int fr, int fq) const {
        const int row0 = u.pm * BM + wr * 64 + fr; const int col0 = u.pn * BM + wc * 32 + 8 * fq;
        const float* src = nullptr;
        if (B0) src = (u.pm * BM < split) ? B0 + (size_t)row0 * ldc + col0 : B1 + (size_t)(row0 - split) * ldc + col0;
        bf16_t* hb = H + (size_t)row0 * ldc + col0;
#pragma unroll
        for (int ai = 0; ai < 2; ++ai)
#pragma unroll
            for (int m = 0; m < 4; ++m) { const size_t ro = (size_t)(ai * HALF + m * 16) * ldc; float ss = 0.f;
#pragma unroll
                for (int bj = 0; bj < 2; ++bj) {
                    f32x4 o0, o1;
                    if (B0) { o0 = *(const f32x4*)(src + ro + bj * HALF); o1 = *(const f32x4*)(src + ro + bj * HALF + 4); }
                    else { const u32x4 hw = *(const u32x4*)(hb + ro + bj * HALF);
                           o0[0] = __uint_as_float(hw.x << 16); o0[1] = __uint_as_float(hw.x & 0xffff0000u); o0[2] = __uint_as_float(hw.y << 16); o0[3] = __uint_as_float(hw.y & 0xffff0000u);
                           o1[0] = __uint_as_float(hw.z << 16); o1[1] = __uint_as_float(hw.z & 0xffff0000u); o1[2] = __uint_as_float(hw.w << 16); o1[3] = __uint_as_float(hw.w & 0xffff0000u); }
                    const f32x4 v0 = o0 + acc[ai][bj][m][0], v1 = o1 + acc[ai][bj][m][1];
                    u32x4 w; w.x = cvt_pk_bf16(v0[0], v0[1]); w.y = cvt_pk_bf16(v0[2], v0[3]); w.z = cvt_pk_bf16(v1[0], v1[1]); w.w = cvt_pk_bf16(v1[2], v1[3]);
                    *(u32x4*)(hb + ro + bj * HALF) = w;
                    ss += ((v0[0] * v0[0] + v0[1] * v0[1]) + (v0[2] * v0[2] + v0[3] * v0[3])) + ((v1[0] * v1[0] + v1[1] * v1[1]) + (v1[2] * v1[2] + v1[3] * v1[3])); }
                ss += __shfl_xor(ss, 16); ss += __shfl_xor(ss, 32); if (fq == 0) rss[(size_t)(row0 + ai * HALF + m * 16) * 16 + 4 * u.pn + wc] = ss; }
    }
};

template <class Epi, class Sched, bool ALIGN_EPI = false, bool SP2 = false>
__device__ __forceinline__ void gemm_phase(PG8_LAS unsigned char* lds, const Gemm g, const Sched& S, const Epi& E) {
    int tid_ = threadIdx.x; asm volatile("" : "+v"(tid_));
    const int tid = tid_, wid = __builtin_amdgcn_readfirstlane(tid >> 6), lane = tid & 63, wr = wid >> 2, wc = wid & 3, fr = lane & 15, fq = lane >> 4;
    const int K = g.K, nt = K / BK;
    unsigned voffA[2], voffB[2];
#pragma unroll
    for (int i = 0; i < 2; ++i) { int R, C; stage_rc(tid * 16 + i * 8192, R, C); const int Rb = Epi::PERM ? ((R & ~31) + perm32(R & 31)) : R;
        voffA[i] = (unsigned)(R * K + C) * 2u; voffB[i] = (unsigned)(Rb * K + C) * 2u; }
    const size_t kstep = (size_t)(BK * 2);
    const size_t hstep = (size_t)HALF * K * 2;
    const size_t tstep = 2 * hstep;
    const unsigned ldsw = (unsigned)wid * 1024u;
    const int aoff = lds_byte(wr * 64 + fr, fq * 8), boff = lds_byte(wc * 32 + fr, fq * 8);
#define PG8_SA(b, h) (((b) * 2 + (h)) * HTB)
#define PG8_SB(b, h) ((4 + (b) * 2 + (h)) * HTB)
#define PG8_STAGE(bufoff, gbase, voff) do { _Pragma("unroll") for (int _i = 0; _i < 2; ++_i) \
        __builtin_amdgcn_global_load_lds((const unsigned*)((const char*)(gbase) + (voff)[_i]), (PG8_LAS unsigned*)(lds + (bufoff) + ldsw + _i * 8192), 16, 0, 0); } while (0)
#define PG8_LDA(dst, b, h) do { _Pragma("unroll") for (int m = 0; m < 4; ++m) _Pragma("unroll") for (int k = 0; k < 2; ++k) dst[m][k] = *(const PG8_LAS bf16x8*)(lds + PG8_SA(b, h) + aoff + m * 2048 + k * 1024); } while (0)
#define PG8_LDB(dst, b, h) do { _Pragma("unroll") for (int n = 0; n < 2; ++n) _Pragma("unroll") for (int k = 0; k < 2; ++k) dst[n][k] = *(const PG8_LAS bf16x8*)(lds + PG8_SB(b, h) + boff + n * 2048 + k * 1024); } while (0)
#define PG8_MMA(ai, bj, At, Bt) do { __builtin_amdgcn_s_setprio(1); _Pragma("unroll") for (int m = 0; m < 4; ++m) _Pragma("unroll") for (int n = 0; n < 2; ++n) _Pragma("unroll") for (int k = 0; k < 2; ++k) \
        acc[ai][bj][m][n] = __builtin_amdgcn_mfma_f32_16x16x32_bf16(Bt[n][k], At[m][k], acc[ai][bj][m][n], 0, 0, 0); __builtin_amdgcn_s_setprio(0); } while (0)
#define PG8_WAIT_V(n) asm volatile("s_waitcnt vmcnt(" #n ")" ::: "memory")
#define PG8_WAIT_L(n) asm volatile("s_waitcnt lgkmcnt(" #n ")" ::: "memory")
#define PG8_BAR __builtin_amdgcn_s_barrier()
#define PG8_SCHED __builtin_amdgcn_sched_barrier(0)
    Unit cur, nxt; int ui = 0;
    if (!S.next(0, cur)) return;
    f32x4 acc[2][2][4][2];
#pragma unroll
    for (int a = 0; a < 2; ++a)
#pragma unroll
        for (int b = 0; b < 2; ++b)
#pragma unroll
            for (int m = 0; m < 4; ++m)
#pragma unroll
                for (int n = 0; n < 2; ++n) acc[a][b][m][n] = (f32x4){0.f, 0.f, 0.f, 0.f};
    bf16x8 At[4][2], B0[2][2], B1[2][2];
    const char* cA = (const char*)g.A + (size_t)cur.pm * tstep; const char* cB = (const char*)g.Bt + (size_t)cur.pn * tstep;
    S.a_ready(cur);
    if constexpr (SP2) {
        PG8_STAGE(PG8_SB(0, 0), cB, voffB); PG8_STAGE(PG8_SB(0, 1), cB + hstep, voffB); PG8_STAGE(PG8_SA(0, 0), cA, voffA); PG8_STAGE(PG8_SA(0, 1), cA + hstep, voffA);
        if (wr == 1) PG8_BAR;
        PG8_WAIT_V(2); PG8_BAR;
        PG8_STAGE(PG8_SB(1, 0), cB + kstep, voffB); PG8_STAGE(PG8_SA(1, 0), cA + kstep, voffA); PG8_STAGE(PG8_SB(1, 1), cB + hstep + kstep, voffB);
        PG8_WAIT_V(6); PG8_BAR;
    } else {
        PG8_STAGE(PG8_SB(0, 0), cB, voffB); PG8_STAGE(PG8_SA(0, 0), cA, voffA); PG8_STAGE(PG8_SB(0, 1), cB + hstep, voffB); PG8_STAGE(PG8_SA(0, 1), cA + hstep, voffA);
        if (wr == 1) PG8_BAR;
        PG8_WAIT_V(4); PG8_BAR;
        PG8_STAGE(PG8_SB(1, 0), cB + kstep, voffB); PG8_STAGE(PG8_SA(1, 0), cA + kstep, voffA); PG8_STAGE(PG8_SB(1, 1), cB + hstep + kstep, voffB);
        PG8_WAIT_V(6); PG8_BAR;
    }
    for (;;) {
        const bool has_next = S.next(ui + 1, nxt);
        const char* nA = has_next ? (const char*)g.A + (size_t)nxt.pm * tstep : cA; const char* nB = has_next ? (const char*)g.Bt + (size_t)nxt.pn * tstep : cB;
        for (int t = 0; t < nt; t += 2) {
            const bool last = (t == nt - 2);
            const char* a1 = cA + (size_t)(t + 1) * kstep;
            const char* a2 = last ? nA : cA + (size_t)(t + 2) * kstep; const char* b2 = last ? nB : cB + (size_t)(t + 2) * kstep;
            const char* a3 = a2 + kstep; const char* b3 = b2 + kstep;
            if (last && has_next) S.a_ready(nxt);
            if constexpr (SP2) {
            PG8_LDB(B0, 0, 0); PG8_LDB(B1, 0, 1); PG8_SCHED; PG8_LDA(At, 0, 0); PG8_STAGE(PG8_SA(1, 1), a1 + hstep, voffA);
            PG8_WAIT_V(8); PG8_WAIT_L(0); PG8_BAR; PG8_MMA(0, 0, At, B0); PG8_MMA(0, 1, At, B1); PG8_BAR; PG8_SCHED;
            PG8_LDA(At, 0, 1); PG8_STAGE(PG8_SB(0, 0), b2, voffB); PG8_STAGE(PG8_SB(0, 1), b2 + hstep, voffB); PG8_STAGE(PG8_SA(0, 0), a2, voffA);
            PG8_WAIT_V(8); PG8_WAIT_L(0); PG8_BAR; PG8_MMA(1, 0, At, B0); PG8_MMA(1, 1, At, B1); PG8_BAR; PG8_SCHED;
            PG8_LDB(B0, 1, 0); PG8_LDB(B1, 1, 1); PG8_SCHED; PG8_LDA(At, 1, 0); PG8_STAGE(PG8_SA(0, 1), a2 + hstep, voffA);
            PG8_WAIT_V(8); PG8_WAIT_L(0); PG8_BAR; PG8_MMA(0, 0, At, B0); PG8_MMA(0, 1, At, B1); PG8_BAR; PG8_SCHED;
            PG8_LDA(At, 1, 1); PG8_STAGE(PG8_SB(1, 0), b3, voffB); PG8_STAGE(PG8_SB(1, 1), b3 + hstep, voffB); PG8_STAGE(PG8_SA(1, 0), a3, voffA);
            PG8_WAIT_V(8); PG8_WAIT_L(0); PG8_BAR; PG8_MMA(1, 0, At, B0); PG8_MMA(1, 1, At, B1); PG8_BAR; PG8_SCHED;
            } else {
            PG8_LDB(B0, 0, 0); PG8_SCHED; PG8_LDA(At, 0, 0); PG8_STAGE(PG8_SA(1, 1), a1 + hstep, voffA);
            PG8_WAIT_L(8); PG8_BAR; PG8_WAIT_L(0); PG8_MMA(0, 0, At, B0); PG8_BAR; PG8_SCHED;
            PG8_LDB(B1, 0, 1); PG8_STAGE(PG8_SB(0, 0), b2, voffB);
            PG8_BAR; PG8_WAIT_L(0); PG8_MMA(0, 1, At, B1); PG8_BAR;
            PG8_LDA(At, 0, 1); PG8_STAGE(PG8_SA(0, 0), a2, voffA);
            PG8_BAR; PG8_WAIT_L(0); PG8_MMA(1, 0, At, B0); PG8_BAR; PG8_SCHED;
            PG8_STAGE(PG8_SB(0, 1), b2 + hstep, voffB);
            PG8_WAIT_V(6); PG8_BAR; PG8_MMA(1, 1, At, B1); PG8_BAR;
            PG8_LDB(B0, 1, 0); PG8_SCHED; PG8_LDA(At, 1, 0); PG8_STAGE(PG8_SA(0, 1), a2 + hstep, voffA);
            PG8_WAIT_L(8); PG8_BAR; PG8_WAIT_L(0); PG8_MMA(0, 0, At, B0); PG8_BAR; PG8_SCHED;
            PG8_LDB(B1, 1, 1); PG8_STAGE(PG8_SB(1, 0), b3, voffB);
            PG8_BAR; PG8_WAIT_L(0); PG8_MMA(0, 1, At, B1); PG8_BAR;
            PG8_LDA(At, 1, 1); PG8_STAGE(PG8_SA(1, 0), a3, voffA);
            PG8_BAR; PG8_WAIT_L(0); PG8_MMA(1, 0, At, B0); PG8_BAR; PG8_SCHED;
            PG8_STAGE(PG8_SB(1, 1), b3 + hstep, voffB);
            PG8_WAIT_V(6); PG8_BAR; PG8_MMA(1, 1, At, B1); PG8_BAR;
            }
        }
        if constexpr (ALIGN_EPI) { if (wr == 0) PG8_BAR; }
        if constexpr (!Epi::AFTER_DRAIN) { E(acc, cur, wr, wc, fr, fq); S.done(cur); }
        if (!has_next) break;
#pragma unroll
        for (int a = 0; a < 2; ++a)
#pragma unroll
            for (int b = 0; b < 2; ++b)
#pragma unroll
                for (int m = 0; m < 4; ++m)
#pragma unroll
                    for (int n = 0; n < 2; ++n) acc[a][b][m][n] = (f32x4){0.f, 0.f, 0.f, 0.f};
        cur = nxt; cA = nA; cB = nB; ++ui;
        if constexpr (ALIGN_EPI) { if (wr == 1) PG8_BAR; }
    }
    PG8_WAIT_V(0);
    if constexpr (!ALIGN_EPI) { if (wr == 0) PG8_BAR; }
    PG8_BAR;
    if constexpr (Epi::AFTER_DRAIN) { E.fused(acc, cur, wr, wc, fr, fq, lds, wid, lane); S.done(cur); }
#undef PG8_SA
#undef PG8_SB
#undef PG8_STAGE
#undef PG8_LDA
#undef PG8_LDB
#undef PG8_MMA
#undef PG8_WAIT_V
#undef PG8_WAIT_L
#undef PG8_BAR
#undef PG8_SCHED
}
}
#define PG8_SP2 true
#define PG8_ALIGN true

typedef unsigned short bf16_t;
typedef short bf16x8 __attribute__((ext_vector_type(8)));
typedef short s16x4 __attribute__((ext_vector_type(4)));
typedef float f32x4 __attribute__((ext_vector_type(4)));
typedef float f32x16 __attribute__((ext_vector_type(16)));
typedef unsigned u32x4 __attribute__((ext_vector_type(4)));
typedef unsigned u32x2 __attribute__((ext_vector_type(2)));
#define LAS __attribute__((address_space(3)))

constexpr int DM = 1024, FF = 4096;
constexpr int MP = 8 * 2048, MS = 16 * 4096, MT = MP + MS;
constexpr int NE = 2304, NO = 3072;
constexpr int NWAVES = 8, NTHREADS = 512;
constexpr size_t MiB = 1u << 20;
constexpr size_t WS_ROPE_C = 0, WS_ROPE_S = 512 * 1024, WS_AX_C = 1 * MiB, WS_AX_S = 1 * MiB + 4096;
constexpr size_t WS_WINE = 2 * MiB;
constexpr size_t WS_WOUTE = WS_WINE + (size_t)NE * DM * 2;
constexpr size_t WS_WINO = WS_WOUTE + (size_t)DM * DM * 2;
constexpr size_t WS_WOUTO = WS_WINO + (size_t)NO * DM * 2;
constexpr size_t WS_WUP = WS_WOUTO + (size_t)DM * DM * 2;
constexpr size_t WS_WDN = WS_WUP + (size_t)2 * FF * DM * 2;
constexpr size_t WS_WEND = WS_WDN + (size_t)2 * FF * DM * 2;
static_assert(WS_WEND <= 52 * MiB, "weights");
constexpr size_t WS_BAR = 1 * MiB + 64 * 1024, BAR_BYTES = 16384;
constexpr size_t WS_RSS = 864 * MiB;
constexpr size_t WS_H = 64 * MiB;
constexpr size_t WS_PROJ = 224 * MiB;
constexpr size_t WS_ATT = 704 * MiB;
constexpr size_t WS_HID = 224 * MiB;
constexpr size_t WS_END = 896 * MiB;
constexpr int LDS_BYTES = 147456;
constexpr size_t RS = (size_t)MT * 16;
constexpr int A_KOFF = 0, A_VOFF = 16384, A_RPB = 49152, A_STASH = 65536;
constexpr float LOG2E = 1.4426950408889634f;

struct Params { const float* in[20]; float* out; unsigned char* ws; };

__device__ __forceinline__ float wave_sum(float v) {
#pragma unroll
    for (int o = 1; o < 64; o <<= 1) v += __shfl_xor(v, o);
    return v;
}
__device__ __forceinline__ unsigned pk2(float lo, float hi) { return pg8::cvt_pk_bf16(lo, hi); }
__device__ __forceinline__ float bf_lo(unsigned u) { return __uint_as_float(u << 16); }
__device__ __forceinline__ float bf_hi(unsigned u) { return __uint_as_float(u & 0xffff0000u); }
__device__ __forceinline__ float bf2f(bf16_t b) { return __uint_as_float(((unsigned)b) << 16); }
__device__ __forceinline__ bf16_t f2bf(float f) { return (bf16_t)(pg8::cvt_pk_bf16(f, 0.f) & 0xffffu); }

__device__ __forceinline__ void transpose_item(const float* W, int K, int N, bf16_t* WT, float* scr, int item, int lane, int pmode, const float* g  ) {
    const int nblk = N / 32, kb = item / nblk, nb = item % nblk, k0 = 64 * kb, n0 = 32 * nb;
    const int ncol = (pmode < 0) ? (n0 + (lane & 31)) : pg8::proj_phys_to_log(pmode, n0 + (lane & 31));
#pragma unroll 8
    for (int i = 0; i < 32; ++i) { const int kk = 2 * i + (lane >> 5); const float gv = g ? g[k0 + kk] : 1.0f; scr[kk * 33 + (lane & 31)] = W[(size_t)(k0 + kk) * N + ncol] * gv; }
    __builtin_amdgcn_s_waitcnt(0); asm volatile("" ::: "memory");
    const int c = lane & 7;
#pragma unroll
    for (int j = 0; j < 4; ++j) { const int n = (lane >> 3) + 8 * j; const float* s = scr + (8 * c) * 33 + n;
        u32x4 o; o.x = pk2(s[0 * 33], s[1 * 33]); o.y = pk2(s[2 * 33], s[3 * 33]); o.z = pk2(s[4 * 33], s[5 * 33]); o.w = pk2(s[6 * 33], s[7 * 33]);
        *(u32x4*)(WT + (size_t)(n0 + n) * K + k0 + 8 * c) = o; }
    __builtin_amdgcn_s_waitcnt(0); asm volatile("" ::: "memory");
}
__device__ __forceinline__ void rms_row_bf16(const float* xrow, const float* g, bf16_t* orow, float* copyrow, int lane) {
    const f32x4* xr = (const f32x4*)xrow + lane;
    f32x4 v[4]; float s = 0.f;
#pragma unroll
    for (int j = 0; j < 4; ++j) { v[j] = xr[64 * j]; s += (v[j].x * v[j].x + v[j].y * v[j].y) + (v[j].z * v[j].z + v[j].w * v[j].w); }
    const float rstd = 1.0f / sqrtf(wave_sum(s) * (1.f / DM) + 1e-6f);
#pragma unroll
    for (int j = 0; j < 4; ++j) { const f32x4 gg = ((const f32x4*)g)[lane + 64 * j];
        u32x2 w; w.x = pk2(v[j].x * rstd * gg.x, v[j].y * rstd * gg.y); w.y = pk2(v[j].z * rstd * gg.z, v[j].w * rstd * gg.w);
        *((u32x2*)orow + lane + 64 * j) = w;
        if (copyrow) ((f32x4*)copyrow)[lane + 64 * j] = v[j]; }
}
__device__ __forceinline__ void cvt_row_bf16(const float* xrow, bf16_t* orow, float* rss_out, int lane) {
    const f32x4* xr = (const f32x4*)xrow + lane;
    f32x4 v[4]; float s = 0.f;
#pragma unroll
    for (int j = 0; j < 4; ++j) { v[j] = xr[64 * j]; s += (v[j].x * v[j].x + v[j].y * v[j].y) + (v[j].z * v[j].z + v[j].w * v[j].w); }
    s = wave_sum(s);
#pragma unroll
    for (int j = 0; j < 4; ++j) { u32x2 w; w.x = pk2(v[j].x, v[j].y); w.y = pk2(v[j].z, v[j].w); *((u32x2*)orow + lane + 64 * j) = w; }
    if (lane < 16) rss_out[lane] = (lane == 0) ? s : 0.f;
}
__device__ __forceinline__ void cvt_row_bf16_x2(const float* xa, const float* xb, bf16_t* oa, bf16_t* ob, float* ra, float* rb, int lane) {
    const f32x4* pa = (const f32x4*)xa + lane; const f32x4* pb = (const f32x4*)xb + lane;
    f32x4 v[4], w[4]; float s = 0.f, q = 0.f;
#pragma unroll
    for (int j = 0; j < 4; ++j) { v[j] = pa[64 * j]; w[j] = pb[64 * j]; }
#pragma unroll
    for (int j = 0; j < 4; ++j) { s += (v[j].x * v[j].x + v[j].y * v[j].y) + (v[j].z * v[j].z + v[j].w * v[j].w); q += (w[j].x * w[j].x + w[j].y * w[j].y) + (w[j].z * w[j].z + w[j].w * w[j].w); }
    s = wave_sum(s); q = wave_sum(q);
#pragma unroll
    for (int j = 0; j < 4; ++j) { u32x2 a; a.x = pk2(v[j].x, v[j].y); a.y = pk2(v[j].z, v[j].w); *((u32x2*)oa + lane + 64 * j) = a;
                                  u32x2 b; b.x = pk2(w[j].x, w[j].y); b.y = pk2(w[j].z, w[j].w); *((u32x2*)ob + lane + 64 * j) = b; }
    if (lane < 16) { ra[lane] = (lane == 0) ? s : 0.f; rb[lane] = (lane == 0) ? q : 0.f; }
}
__device__ __forceinline__ void final_row_x2(const bf16_t* ha, const bf16_t* hb, float rsa, float rsb, const float* g, float* oa, float* ob, int lane) {
    u32x4 x[2], y[2];
#pragma unroll
    for (int j = 0; j < 2; ++j) { x[j] = *((const u32x4*)ha + lane + 64 * j); y[j] = *((const u32x4*)hb + lane + 64 * j); }
#pragma unroll
    for (int j = 0; j < 2; ++j) {
        const f32x4 g0 = *((const f32x4*)g + 2 * (lane + 64 * j)), g1 = *((const f32x4*)g + 2 * (lane + 64 * j) + 1);
        f32x4 o0, o1;
        o0.x = bf_lo(x[j].x) * rsa * g0.x; o0.y = bf_hi(x[j].x) * rsa * g0.y; o0.z = bf_lo(x[j].y) * rsa * g0.z; o0.w = bf_hi(x[j].y) * rsa * g0.w;
        o1.x = bf_lo(x[j].z) * rsa * g1.x; o1.y = bf_hi(x[j].z) * rsa * g1.y; o1.z = bf_lo(x[j].w) * rsa * g1.z; o1.w = bf_hi(x[j].w) * rsa * g1.w;
        *((f32x4*)oa + 2 * (lane + 64 * j)) = o0; *((f32x4*)oa + 2 * (lane + 64 * j) + 1) = o1;
        o0.x = bf_lo(y[j].x) * rsb * g0.x; o0.y = bf_hi(y[j].x) * rsb * g0.y; o0.z = bf_lo(y[j].y) * rsb * g0.z; o0.w = bf_hi(y[j].y) * rsb * g0.w;
        o1.x = bf_lo(y[j].z) * rsb * g1.x; o1.y = bf_hi(y[j].z) * rsb * g1.y; o1.z = bf_lo(y[j].w) * rsb * g1.z; o1.w = bf_hi(y[j].w) * rsb * g1.w;
        *((f32x4*)ob + 2 * (lane + 64 * j)) = o0; *((f32x4*)ob + 2 * (lane + 64 * j) + 1) = o1;
    }
}
__device__ __forceinline__ void final_row(const bf16_t* hrow, float rstd, const float* g, float* orow, int lane) {
#pragma unroll
    for (int j = 0; j < 2; ++j) {
        const u32x4 hw = *((const u32x4*)hrow + lane + 64 * j);
        const f32x4 g0 = *((const f32x4*)g + 2 * (lane + 64 * j)), g1 = *((const f32x4*)g + 2 * (lane + 64 * j) + 1);
        f32x4 o0, o1;
        o0.x = bf_lo(hw.x) * rstd * g0.x; o0.y = bf_hi(hw.x) * rstd * g0.y; o0.z = bf_lo(hw.y) * rstd * g0.z; o0.w = bf_hi(hw.y) * rstd * g0.w;
        o1.x = bf_lo(hw.z) * rstd * g1.x; o1.y = bf_hi(hw.z) * rstd * g1.y; o1.z = bf_lo(hw.w) * rstd * g1.z; o1.w = bf_hi(hw.w) * rstd * g1.w;
        *((f32x4*)orow + 2 * (lane + 64 * j)) = o0; *((f32x4*)orow + 2 * (lane + 64 * j) + 1) = o1;
    }
}
__device__ __forceinline__ void rms_row_f32_inplace(float* xrow, const float* g, int lane) {
    f32x4* xr = (f32x4*)xrow + lane;
    f32x4 v[4]; float s = 0.f;
#pragma unroll
    for (int j = 0; j < 4; ++j) { v[j] = xr[64 * j]; s += (v[j].x * v[j].x + v[j].y * v[j].y) + (v[j].z * v[j].z + v[j].w * v[j].w); }
    const float rstd = 1.0f / sqrtf(wave_sum(s) * (1.f / DM) + 1e-6f);
#pragma unroll
    for (int j = 0; j < 4; ++j) { const f32x4 gg = ((const f32x4*)g)[lane + 64 * j]; f32x4 o; o.x = v[j].x * rstd * gg.x; o.y = v[j].y * rstd * gg.y; o.z = v[j].z * rstd * gg.z; o.w = v[j].w * rstd * gg.w; xr[64 * j] = o; }
}
__device__ __forceinline__ void cs_of(float ang, float& c, float& s) {
    const double rev = (double)ang * 0.15915494309189535; const float fr = (float)(rev - floor(rev));
    c = __builtin_amdgcn_cosf(fr); s = __builtin_amdgcn_sinf(fr);
}

__device__ __forceinline__ int crow(int r, int hi) { return (r & 3) + 8 * (r >> 2) + 4 * hi; }
#define MFMA32(a, b, c) __builtin_amdgcn_mfma_f32_32x32x16_bf16((a), (b), (c), 0, 0, 0)
typedef short v4i16_t __attribute__((ext_vector_type(4)));
__device__ __forceinline__ float max3f(float a, float b, float c) { float r; asm("v_max3_f32 %0, %1, %2, %3" : "=v"(r) : "v"(a), "v"(b), "v"(c)); return r; }
__device__ __forceinline__ s16x4 vtr(const LAS char* p) { return __builtin_bit_cast(s16x4, __builtin_amdgcn_ds_read_tr16_b64_v4i16((LAS v4i16_t*)p)); }

template <int DV, bool NA>
__device__ __forceinline__ void tile_compute(char* lds, int buf, int t, const bf16x8 (&qf)[4], int koff, int vlane, int r32, int hi, float sc, int na_qc0, int na_r,
                                             f32x16 (&o)[DV / 32], float& m_run, float& l_run) {
    constexpr int NDB = DV / 32;
    const char* Kb = lds + A_KOFF + buf * 8192;
    const LAS char* Vb = (const LAS char*)(lds + A_VOFF + buf * 16384 + vlane);
    bf16x8 kf0[4], kf1[4];
    if (NDB == 2) {
#pragma unroll
        for (int d0 = 0; d0 < 4; ++d0) {
            const int off = koff + (((2 * d0 + hi) ^ ((r32 >> 1) & 7)) << 4);
            kf0[d0] = *(const bf16x8*)(Kb + off);
            kf1[d0] = *(const bf16x8*)(Kb + 4096 + off);
        }
    }
    constexpr int NPRE = 2;
    s16x4 vlo[NPRE][4], vhh[NPRE][4];
    if (NDB == 2) {
#pragma unroll
        for (int g = 0; g < NPRE; ++g)
#pragma unroll
            for (int s = 0; s < 4; ++s) { vlo[g][s] = vtr(Vb + g * 4096 + s * 1024); vhh[g][s] = vtr(Vb + g * 4096 + s * 1024 + 512); }
    }
    f32x16 s0, s1;
#pragma unroll
    for (int i = 0; i < 16; ++i) { s0[i] = 0.f; s1[i] = 0.f; }
    if (NDB == 2) {
#pragma unroll
        for (int d0 = 0; d0 < 4; ++d0) { s0 = MFMA32(kf0[d0], qf[d0], s0); s1 = MFMA32(kf1[d0], qf[d0], s1); }
    } else {
#pragma unroll
        for (int d0 = 0; d0 < 4; ++d0) {
            const int off = koff + (((2 * d0 + hi) ^ ((r32 >> 1) & 7)) << 4);
            const bf16x8 k0 = *(const bf16x8*)(Kb + off);
            const bf16x8 k1 = *(const bf16x8*)(Kb + 4096 + off);
            s0 = MFMA32(k0, qf[d0], s0); s1 = MFMA32(k1, qf[d0], s1);
        }
    }
    float mx = -1e30f;
    if (NA) {
        const int qc = na_qc0 + r32; const int win0 = min(max(qc - 8, 0), 48);
        const float* rp = (const float*)(lds + A_RPB) + (t - na_r + 7) * 31 + (15 - qc);
#pragma unroll
        for (int i = 0; i < 16; ++i) {
            const int kc = crow(i, hi), kc1 = kc + 32;
            const bool v0 = (kc >= win0) && (kc < win0 + 16), v1 = (kc1 >= win0) && (kc1 < win0 + 16);
            s0[i] = v0 ? fmaf(s0[i], sc, rp[kc]) : -1e30f;
            s1[i] = v1 ? fmaf(s1[i], sc, rp[kc1]) : -1e30f;
        }
#pragma unroll
        for (int i = 0; i < 16; ++i) mx = max3f(mx, s0[i], s1[i]);
    } else {
        asm volatile("s_nop 15\n\ts_nop 7" : "+v"(s0), "+v"(s1));
#pragma unroll
        for (int i = 0; i < 16; ++i) mx = max3f(mx, s0[i], s1[i]);
        mx *= sc;
    }
    mx = fmaxf(mx, __shfl_xor(mx, 32));
    const float m_new = fmaxf(m_run, mx);
    if (__any(m_new > m_run)) {
        const float alpha = __builtin_amdgcn_exp2f(m_run - m_new);
        l_run *= alpha;
#pragma unroll
        for (int db = 0; db < NDB; ++db)
#pragma unroll
            for (int i = 0; i < 16; ++i) o[db][i] *= alpha;
        m_run = m_new;
    }
    float rs = 0.f;
    if (NA) {
#pragma unroll
        for (int i = 0; i < 16; ++i) { s0[i] = __builtin_amdgcn_exp2f(s0[i] - m_new); s1[i] = __builtin_amdgcn_exp2f(s1[i] - m_new); rs += s0[i] + s1[i]; }
    } else {
#pragma unroll
        for (int i = 0; i < 16; ++i) { s0[i] = __builtin_amdgcn_exp2f(fmaf(s0[i], sc, -m_new)); s1[i] = __builtin_amdgcn_exp2f(fmaf(s1[i], sc, -m_new)); rs += s0[i] + s1[i]; }
    }
    l_run += rs;
    bf16x8 pa[4];
    {
        u32x4 w;
        w.x = pk2(s0[0], s0[1]); w.y = pk2(s0[2], s0[3]); w.z = pk2(s0[4], s0[5]); w.w = pk2(s0[6], s0[7]); pa[0] = __builtin_bit_cast(bf16x8, w);
        w.x = pk2(s0[8], s0[9]); w.y = pk2(s0[10], s0[11]); w.z = pk2(s0[12], s0[13]); w.w = pk2(s0[14], s0[15]); pa[1] = __builtin_bit_cast(bf16x8, w);
        w.x = pk2(s1[0], s1[1]); w.y = pk2(s1[2], s1[3]); w.z = pk2(s1[4], s1[5]); w.w = pk2(s1[6], s1[7]); pa[2] = __builtin_bit_cast(bf16x8, w);
        w.x = pk2(s1[8], s1[9]); w.y = pk2(s1[10], s1[11]); w.z = pk2(s1[12], s1[13]); w.w = pk2(s1[14], s1[15]); pa[3] = __builtin_bit_cast(bf16x8, w);
    }
    if (NDB == 2) {
#pragma unroll
        for (int s = 0; s < 4; ++s) {
            o[0] = MFMA32(__builtin_shufflevector(vlo[0][s], vhh[0][s], 0, 1, 2, 3, 4, 5, 6, 7), pa[s], o[0]);
            o[1] = MFMA32(__builtin_shufflevector(vlo[NPRE - 1][s], vhh[NPRE - 1][s], 0, 1, 2, 3, 4, 5, 6, 7), pa[s], o[1]);
        }
    } else {
        s16x4 clo[4], chh[4];
#pragma unroll
        for (int s = 0; s < 4; ++s) { clo[s] = vtr(Vb + s * 1024); chh[s] = vtr(Vb + s * 1024 + 512); }
#pragma unroll
        for (int db = 0; db < NDB; ++db) {
            s16x4 nlo[4], nhh[4];
            if (db + 1 < NDB) {
#pragma unroll
                for (int s = 0; s < 4; ++s) { nlo[s] = vtr(Vb + (db + 1) * 4096 + s * 1024); nhh[s] = vtr(Vb + (db + 1) * 4096 + s * 1024 + 512); }
            }
#pragma unroll
            for (int s = 0; s < 4; ++s) o[db] = MFMA32(__builtin_shufflevector(clo[s], chh[s], 0, 1, 2, 3, 4, 5, 6, 7), pa[s], o[db]);
            if (db + 1 < NDB) {
#pragma unroll
                for (int s = 0; s < 4; ++s) { clo[s] = nlo[s]; chh[s] = nhh[s]; }
            }
        }
    }
}

template <int DV, bool NA>
__device__ __forceinline__ void flash_pass(char* lds, const bf16_t* Qw, const bf16_t* Kh, const bf16_t* Vh, int pitch,
                                           int tb, int te, int wb, int we, float sc, int na_qc0, int na_r, f32x16 (&o)[DV / 32], float& l_tot) {
    constexpr int NVL = DV / 64, NDB = DV / 32;
    int tid_ = threadIdx.x; asm volatile("" : "+v"(tid_));
    const int tid = tid_, lane = tid & 63, r32 = lane & 31, hi = lane >> 5;
    bf16x8 qf[4];
#pragma unroll
    for (int d0 = 0; d0 < 4; ++d0) qf[d0] = *(const bf16x8*)(Qw + (size_t)r32 * pitch + d0 * 16 + hi * 8);
    float m_run = -1e30f, l_run = 0.f;
#pragma unroll
    for (int db = 0; db < NDB; ++db)
#pragma unroll
        for (int i = 0; i < 16; ++i) o[db][i] = 0.f;
    const int krow = tid >> 3, kch = tid & 7;
    const int kdst = krow * 128 + ((kch ^ ((krow >> 1) & 7)) << 4);
    const bf16_t* ksrc = Kh + (size_t)krow * pitch + kch * 8;
    int vdst[NVL]; const bf16_t* vsrc[NVL];
#pragma unroll
    for (int i = 0; i < NVL; ++i) {
        const int vrow = (NVL == 1) ? (tid >> 3) : ((tid >> 4) + 32 * i), vch = (NVL == 1) ? (tid & 7) : (tid & 15), d = vch * 8;
        vdst[i] = ((d >> 5) * 8 + (vrow >> 3)) * 512 + (vrow & 7) * 64 + (d & 31) * 2;
        vsrc[i] = Vh + (size_t)vrow * pitch + d;
    }
    const size_t tstride = (size_t)64 * pitch;
    u32x4 kA, vA[NVL], kB, vB[NVL];
#define FP_LOAD(K_, V_, tt) do { K_ = *(const u32x4*)(ksrc + (size_t)(tt) * tstride); _Pragma("unroll") for (int i_ = 0; i_ < NVL; ++i_) V_[i_] = *(const u32x4*)(vsrc[i_] + (size_t)(tt) * tstride); } while (0)
#define FP_WRITE(K_, V_, bb) do { *(u32x4*)(lds + A_KOFF + (bb) * 8192 + kdst) = K_; _Pragma("unroll") for (int i_ = 0; i_ < NVL; ++i_) *(u32x4*)(lds + A_VOFF + (bb) * 16384 + vdst[i_]) = V_[i_]; } while (0)
    FP_LOAD(kA, vA, tb);
    FP_WRITE(kA, vA, 0);
    if (tb + 1 < te) FP_LOAD(kA, vA, tb + 1);
    __syncthreads();
    const int koff = r32 * 128;
    const int vlane = (4 * hi + ((lane & 15) >> 2)) * 64 + ((lane >> 4) & 1) * 32 + (lane & 3) * 8;
    for (int t = tb; t < te; t += 2) {
        if (t + 2 < te) FP_LOAD(kB, vB, t + 2);
        if (t >= wb && t < we) tile_compute<DV, NA>(lds, 0, t, qf, koff, vlane, r32, hi, sc, na_qc0, na_r, o, m_run, l_run);
        if (t + 1 < te) FP_WRITE(kA, vA, 1);
        __syncthreads();
        if (t + 1 >= te) break;
        if (t + 3 < te) FP_LOAD(kA, vA, t + 3);
        if (t + 1 >= wb && t + 1 < we) tile_compute<DV, NA>(lds, 1, t + 1, qf, koff, vlane, r32, hi, sc, na_qc0, na_r, o, m_run, l_run);
        if (t + 2 < te) FP_WRITE(kB, vB, 0);
        __syncthreads();
    }
#undef FP_LOAD
#undef FP_WRITE
    l_tot = l_run + __shfl_xor(l_run, 32);
}

#define VTR_ASM(dst, addr, off) asm volatile("ds_read_b64_tr_b16 %0, %1 offset:%2" : "=&v"(dst) : "v"(addr), "i"(off) : "memory")
#define VSET_WAIT(L, H) asm volatile("s_waitcnt lgkmcnt(0)" : "+v"(L[0]), "+v"(L[1]), "+v"(L[2]), "+v"(L[3]), "+v"(H[0]), "+v"(H[1]), "+v"(H[2]), "+v"(H[3]) :: "memory")
template <int DV, int KOFFB, int VOFFB>
__device__ __forceinline__ void dense_step(char* lds, const bf16x8 (&qf)[4], int koff, int vlane, int r32, int hi, float sc,
                                           f32x16& s0, f32x16& s1, f32x16 (&o)[DV / 32], float& m_run, float& l_run) {
    constexpr int NDB = DV / 32;
    const char* Kb = lds + KOFFB;
    const LAS char* Vb = (const LAS char*)(lds + VOFFB + vlane);
    const unsigned vaddr = (unsigned)(uintptr_t)(lds + vlane);
    constexpr int VO = VOFFB;
    bf16x8 kf0[4], kf1[4];
#pragma unroll
    for (int d0 = 0; d0 < 4; ++d0) {
        const int off = koff + (((2 * d0 + hi) ^ ((r32 >> 1) & 7)) << 4);
        kf0[d0] = *(const bf16x8*)(Kb + off);
        kf1[d0] = *(const bf16x8*)(Kb + 4096 + off);
    }
    s16x4 vlo[2][4], vhh[2][4];
    if (NDB == 2) {
#pragma unroll
        for (int g = 0; g < 2; ++g)
#pragma unroll
            for (int s = 0; s < 4; ++s) { vlo[g][s] = vtr(Vb + g * 4096 + s * 1024); vhh[g][s] = vtr(Vb + g * 4096 + s * 1024 + 512); }
    }
    asm volatile("s_nop 15\n\ts_nop 7" : "+v"(s0), "+v"(s1));
    float mx = -1e30f, mxb = -1e30f;
#pragma unroll
    for (int i = 0; i < 16; i += 2) { mx = max3f(mx, s0[i], s1[i]); mxb = max3f(mxb, s0[i + 1], s1[i + 1]); }
    mx = fmaxf(mx, mxb) * sc;
    mx = fmaxf(mx, __shfl_xor(mx, 32));
    const float m_new = fmaxf(m_run, mx);
    if (__any(m_new > m_run)) {
        const float alpha = __builtin_amdgcn_exp2f(m_run - m_new);
        l_run *= alpha;
#pragma unroll
        for (int db = 0; db < NDB; ++db)
#pragma unroll
            for (int i = 0; i < 16; ++i) o[db][i] *= alpha;
        m_run = m_new;
    }
    s16x4 alo[4], ahh[4], blo[4], bhh[4];
    if (NDB == 4) {
        VTR_ASM(alo[0], vaddr, VO + 0 * 4096); VTR_ASM(ahh[0], vaddr, VO + 0 * 4096 + 512); VTR_ASM(alo[1], vaddr, VO + 1 * 4096); VTR_ASM(ahh[1], vaddr, VO + 1 * 4096 + 512);
        VTR_ASM(alo[2], vaddr, VO + 2 * 4096); VTR_ASM(ahh[2], vaddr, VO + 2 * 4096 + 512); VTR_ASM(alo[3], vaddr, VO + 3 * 4096); VTR_ASM(ahh[3], vaddr, VO + 3 * 4096 + 512);
        VTR_ASM(blo[0], vaddr, VO + 0 * 4096 + 1024); VTR_ASM(bhh[0], vaddr, VO + 0 * 4096 + 1024 + 512); VTR_ASM(blo[1], vaddr, VO + 1 * 4096 + 1024); VTR_ASM(bhh[1], vaddr, VO + 1 * 4096 + 1024 + 512);
        VTR_ASM(blo[2], vaddr, VO + 2 * 4096 + 1024); VTR_ASM(bhh[2], vaddr, VO + 2 * 4096 + 1024 + 512); VTR_ASM(blo[3], vaddr, VO + 3 * 4096 + 1024); VTR_ASM(bhh[3], vaddr, VO + 3 * 4096 + 1024 + 512);
    }
    f32x16 n0, n1;
#pragma unroll
    for (int i = 0; i < 16; ++i) { n0[i] = 0.f; n1[i] = 0.f; }
#pragma unroll
    for (int d0 = 0; d0 < 4; ++d0) { n0 = MFMA32(kf0[d0], qf[d0], n0); n1 = MFMA32(kf1[d0], qf[d0], n1); }
    float rs = 0.f;
#pragma unroll
    for (int i = 0; i < 16; ++i) { s0[i] = __builtin_amdgcn_exp2f(fmaf(s0[i], sc, -m_new)); s1[i] = __builtin_amdgcn_exp2f(fmaf(s1[i], sc, -m_new)); rs += s0[i] + s1[i]; }
    l_run += rs;
    bf16x8 pa[4];
    {
        u32x4 w;
        w.x = pk2(s0[0], s0[1]); w.y = pk2(s0[2], s0[3]); w.z = pk2(s0[4], s0[5]); w.w = pk2(s0[6], s0[7]); pa[0] = __builtin_bit_cast(bf16x8, w);
        w.x = pk2(s0[8], s0[9]); w.y = pk2(s0[10], s0[11]); w.z = pk2(s0[12], s0[13]); w.w = pk2(s0[14], s0[15]); pa[1] = __builtin_bit_cast(bf16x8, w);
        w.x = pk2(s1[0], s1[1]); w.y = pk2(s1[2], s1[3]); w.z = pk2(s1[4], s1[5]); w.w = pk2(s1[6], s1[7]); pa[2] = __builtin_bit_cast(bf16x8, w);
        w.x = pk2(s1[8], s1[9]); w.y = pk2(s1[10], s1[11]); w.z = pk2(s1[12], s1[13]); w.w = pk2(s1[14], s1[15]); pa[3] = __builtin_bit_cast(bf16x8, w);
    }
    if (NDB == 2) {
#pragma unroll
        for (int s = 0; s < 4; ++s) {
            o[0] = MFMA32(__builtin_shufflevector(vlo[0][s], vhh[0][s], 0, 1, 2, 3, 4, 5, 6, 7), pa[s], o[0]);
            o[1] = MFMA32(__builtin_shufflevector(vlo[1][s], vhh[1][s], 0, 1, 2, 3, 4, 5, 6, 7), pa[s], o[1]);
        }
        s0 = n0; s1 = n1;
#pragma unroll
        for (int i = 0; i < 16; ++i) { __builtin_amdgcn_sched_group_barrier(0x008, 1, 0); __builtin_amdgcn_sched_group_barrier(0x002, 6, 0); }
    } else {
#pragma unroll
        for (int i = 0; i < 8; ++i) { __builtin_amdgcn_sched_group_barrier(0x008, 1, 0); __builtin_amdgcn_sched_group_barrier(0x002, 12, 0); }
        __builtin_amdgcn_sched_barrier(0);
#define PV4(L, H, S_) do { _Pragma("unroll") for (int db_ = 0; db_ < 4; ++db_) o[db_] = MFMA32(__builtin_shufflevector(L[db_], H[db_], 0, 1, 2, 3, 4, 5, 6, 7), pa[S_], o[db_]); } while (0)
#define VRD4(L, H, S_) do { VTR_ASM(L[0], vaddr, VO + 0 * 4096 + (S_) * 1024); VTR_ASM(H[0], vaddr, VO + 0 * 4096 + (S_) * 1024 + 512); VTR_ASM(L[1], vaddr, VO + 1 * 4096 + (S_) * 1024); VTR_ASM(H[1], vaddr, VO + 1 * 4096 + (S_) * 1024 + 512); \
                             VTR_ASM(L[2], vaddr, VO + 2 * 4096 + (S_) * 1024); VTR_ASM(H[2], vaddr, VO + 2 * 4096 + (S_) * 1024 + 512); VTR_ASM(L[3], vaddr, VO + 3 * 4096 + (S_) * 1024); VTR_ASM(H[3], vaddr, VO + 3 * 4096 + (S_) * 1024 + 512); } while (0)
        VSET_WAIT(alo, ahh); VSET_WAIT(blo, bhh); __builtin_amdgcn_sched_barrier(0);
        PV4(alo, ahh, 0); __builtin_amdgcn_sched_barrier(0);
        VRD4(alo, ahh, 2); __builtin_amdgcn_sched_barrier(0);
        PV4(blo, bhh, 1); __builtin_amdgcn_sched_barrier(0);
        VSET_WAIT(alo, ahh); VRD4(blo, bhh, 3); __builtin_amdgcn_sched_barrier(0);
        PV4(alo, ahh, 2); __builtin_amdgcn_sched_barrier(0);
        VSET_WAIT(blo, bhh); __builtin_amdgcn_sched_barrier(0);
        PV4(blo, bhh, 3);
#undef PV4
#undef VRD4
        s0 = n0; s1 = n1;
    }
}

template <int DV>
__device__ __forceinline__ void flash_pass_dense(char* lds, const bf16_t* Qw, const bf16_t* Kh, const bf16_t* Vh, int pitch, int NT, float sc,
                                                 f32x16 (&o)[DV / 32], float& l_tot) {
    constexpr int NVL = DV / 64, NDB = DV / 32;
    int tid_ = threadIdx.x; asm volatile("" : "+v"(tid_));
    const int tid = tid_, lane = tid & 63, r32 = lane & 31, hi = lane >> 5;
    if (__builtin_amdgcn_readfirstlane(tid >> 6) >= 4) __builtin_amdgcn_s_setprio(1);
    bf16x8 qf[4];
#pragma unroll
    for (int d0 = 0; d0 < 4; ++d0) qf[d0] = *(const bf16x8*)(Qw + (size_t)r32 * pitch + d0 * 16 + hi * 8);
    float m_run = -1e30f, l_run = 0.f;
#pragma unroll
    for (int db = 0; db < NDB; ++db)
#pragma unroll
        for (int i = 0; i < 16; ++i) o[db][i] = 0.f;
    const int krow = tid >> 3, kch = tid & 7;
    const int kdst = krow * 128 + ((kch ^ ((krow >> 1) & 7)) << 4);
    const bf16_t* ksrc = Kh + (size_t)krow * pitch + kch * 8;
    int vdst[NVL]; const bf16_t* vsrc[NVL];
#pragma unroll
    for (int i = 0; i < NVL; ++i) {
        const int vrow = (NVL == 1) ? (tid >> 3) : ((tid >> 4) + 32 * i), vch = (NVL == 1) ? (tid & 7) : (tid & 15), d = vch * 8;
        vdst[i] = ((d >> 5) * 8 + (vrow >> 3)) * 512 + (vrow & 7) * 64 + (d & 31) * 2;
        vsrc[i] = Vh + (size_t)vrow * pitch + d;
    }
    const size_t tstride = (size_t)64 * pitch;
    const int last = NT - 1;
    u32x4 kA, vA[NVL], kB, vB[NVL];
    const int wv = __builtin_amdgcn_readfirstlane(tid >> 6);
    const int krd = 8 * wv + (lane >> 3);
    const bf16_t* kdma = Kh + (size_t)krd * pitch + 8 * ((lane & 7) ^ ((krd >> 1) & 7));
    const int vj = wv >> 1, vdb0 = (2 * wv) & 3, vdb1 = (2 * wv + 1) & 3;
    const bf16_t* vdma0 = Vh + (size_t)(16 * vj + 8 * (lane >> 5) + ((lane >> 2) & 7)) * pitch + 32 * vdb0 + 8 * (lane & 3);
    const bf16_t* vdma1 = vdma0 + 32 * (vdb1 - vdb0);
    LAS unsigned char* ldsk = (LAS unsigned char*)lds + A_KOFF + wv * 1024;
    LAS unsigned char* ldsv0 = (LAS unsigned char*)lds + A_VOFF + vdb0 * 4096 + vj * 1024;
    LAS unsigned char* ldsv1 = (LAS unsigned char*)lds + A_VOFF + vdb1 * 4096 + vj * 1024;
#define GD_DMA(tk, kb, tv, vb) do { \
        __builtin_amdgcn_global_load_lds((const unsigned*)(kdma + (size_t)min((tk), last) * tstride), (LAS unsigned*)(ldsk + (kb) * 8192), 16, 0, 0); \
        __builtin_amdgcn_global_load_lds((const unsigned*)(vdma0 + (size_t)min((tv), last) * tstride), (LAS unsigned*)(ldsv0 + (vb) * 16384), 16, 0, 0); \
        __builtin_amdgcn_global_load_lds((const unsigned*)(vdma1 + (size_t)min((tv), last) * tstride), (LAS unsigned*)(ldsv1 + (vb) * 16384), 16, 0, 0); } while (0)
#define FD_LOADK(K_, tt) do { K_ = *(const u32x4*)(ksrc + (size_t)min((tt), last) * tstride); } while (0)
#define FD_LOADV(V_, tt) do { _Pragma("unroll") for (int i_ = 0; i_ < NVL; ++i_) V_[i_] = *(const u32x4*)(vsrc[i_] + (size_t)min((tt), last) * tstride); } while (0)
#define FD_WRITEK(K_, bb) do { *(u32x4*)(lds + A_KOFF + (bb) * 8192 + kdst) = K_; } while (0)
#define FD_WRITEV(V_, bb) do { _Pragma("unroll") for (int i_ = 0; i_ < NVL; ++i_) *(u32x4*)(lds + A_VOFF + (bb) * 16384 + vdst[i_]) = V_[i_]; } while (0)
    if (NVL == 1) {
        FD_LOADK(kA, 0); FD_LOADV(vA, 0); FD_LOADK(kB, 1); FD_LOADV(vB, 1);
        *(u32x4*)(lds + 0 * 8192 + kdst) = kA; *(u32x4*)(lds + 32768 + 0 * 8192 + vdst[0]) = vA[0];
        *(u32x4*)(lds + 1 * 8192 + kdst) = kB; *(u32x4*)(lds + 32768 + 1 * 8192 + vdst[0]) = vB[0];
        FD_LOADK(kA, 2);
        *(u32x4*)(lds + 2 * 8192 + kdst) = kA;
    } else {
        GD_DMA(0, 0, 0, 0);
        __builtin_amdgcn_global_load_lds((const unsigned*)(kdma + (size_t)1 * tstride), (LAS unsigned*)(ldsk + 8192), 16, 0, 0);
        asm volatile("s_waitcnt vmcnt(0)" ::: "memory");
    }
    __syncthreads();
    const int koff = r32 * 128;
    const int vlane = (4 * hi + ((lane & 15) >> 2)) * 64 + ((lane >> 4) & 1) * 32 + (lane & 3) * 8;
    f32x16 s0, s1;
    {
#pragma unroll
        for (int i = 0; i < 16; ++i) { s0[i] = 0.f; s1[i] = 0.f; }
        const char* Kb = lds + A_KOFF;
#pragma unroll
        for (int d0 = 0; d0 < 4; ++d0) {
            const int off = koff + (((2 * d0 + hi) ^ ((r32 >> 1) & 7)) << 4);
            const bf16x8 k0 = *(const bf16x8*)(Kb + off), k1 = *(const bf16x8*)(Kb + 4096 + off);
            s0 = MFMA32(k0, qf[d0], s0); s1 = MFMA32(k1, qf[d0], s1);
        }
    }
    __syncthreads();
    if (NVL == 1) {
#define FD4_WK(K_, j) do { *(u32x4*)(lds + (j) * 8192 + kdst) = K_; } while (0)
#define FD4_WV(V_, j) do { *(u32x4*)(lds + 32768 + (j) * 8192 + vdst[0]) = V_[0]; } while (0)
    for (int t = 0; t < NT; t += 4) {
        FD_LOADK(kA, t + 3); FD_LOADV(vA, t + 2); FD_LOADK(kB, t + 4); FD_LOADV(vB, t + 3);
        dense_step<DV, 1 * 8192, 32768 + 0 * 8192>(lds, qf, koff, vlane, r32, hi, sc, s0, s1, o, m_run, l_run);
        dense_step<DV, 2 * 8192, 32768 + 1 * 8192>(lds, qf, koff, vlane, r32, hi, sc, s0, s1, o, m_run, l_run);
        FD4_WK(kA, 3); FD4_WV(vA, 2); FD4_WK(kB, 0); FD4_WV(vB, 3);
        __syncthreads();
        FD_LOADK(kA, t + 5); FD_LOADV(vA, t + 4); FD_LOADK(kB, t + 6); FD_LOADV(vB, t + 5);
        dense_step<DV, 3 * 8192, 32768 + 2 * 8192>(lds, qf, koff, vlane, r32, hi, sc, s0, s1, o, m_run, l_run);
        dense_step<DV, 0 * 8192, 32768 + 3 * 8192>(lds, qf, koff, vlane, r32, hi, sc, s0, s1, o, m_run, l_run);
        FD4_WK(kA, 1); FD4_WV(vA, 0); FD4_WK(kB, 2); FD4_WV(vB, 1);
        __syncthreads();
    }
#undef FD4_WK
#undef FD4_WV
    } else {
    for (int t = 0; t < NT; t += 2) {
        GD_DMA(t + 2, 0, t + 1, 1);
        dense_step<DV, A_KOFF + 8192, A_VOFF>(lds, qf, koff, vlane, r32, hi, sc, s0, s1, o, m_run, l_run);
        asm volatile("s_waitcnt vmcnt(0)" ::: "memory");
        __syncthreads();
        GD_DMA(t + 3, 1, t + 2, 0);
        dense_step<DV, A_KOFF, A_VOFF + 16384>(lds, qf, koff, vlane, r32, hi, sc, s0, s1, o, m_run, l_run);
        asm volatile("s_waitcnt vmcnt(0)" ::: "memory");
        __syncthreads();
    }
    }
#undef GD_DMA
#undef FD_LOADK
#undef FD_LOADV
#undef FD_WRITEK
#undef FD_WRITEV
    __builtin_amdgcn_s_setprio(0);
    l_tot = l_run + __shfl_xor(l_run, 32);
}

__device__ __forceinline__ void store_o64(const f32x16 (&o)[2], float inv, bf16_t* orow  , int hi) {
#pragma unroll
    for (int db = 0; db < 2; ++db)
#pragma unroll
        for (int g = 0; g < 4; ++g) {
            u32x2 w; w.x = pk2(o[db][4 * g] * inv, o[db][4 * g + 1] * inv); w.y = pk2(o[db][4 * g + 2] * inv, o[db][4 * g + 3] * inv);
            *(u32x2*)(orow + 32 * db + 8 * g + 4 * hi) = w;
        }
}

__device__ __forceinline__ void seq_of_unit(int v, int& b, int& h, int& qb, int& T, int& rowbase) {
    if (v < 2048) { qb = v & 15; h = (v >> 4) & 7; b = v >> 7; T = 4096; rowbase = MP + b * 4096; }
    else { const int x = v - 2048; qb = x & 7; h = (x >> 3) & 7; b = x >> 6; T = 2048; rowbase = b * 2048; }
}

#define XB_TMO      128
#define XB_XCNT(j)  (256  + 64 * (j))
#define XB_XSUB(j)  (1280 + 64 * (j))
#define XB_XGEN(j)  (2304 + 64 * (j))
#define XB_TOP      3328
#define XB_TOPGEN   3392
#define XCD_BAR_WORDS 3456
#define XB_SPIN_CAP (1u << 18)

__device__ __forceinline__ unsigned xb_ld(unsigned* p)              { return __hip_atomic_load(p, __ATOMIC_RELAXED, __HIP_MEMORY_SCOPE_AGENT); }
__device__ __forceinline__ unsigned xb_add(unsigned* p, unsigned v) { return __hip_atomic_fetch_add(p, v, __ATOMIC_RELAXED, __HIP_MEMORY_SCOPE_AGENT); }
__device__ __forceinline__ unsigned xb_xcc_id() { return (unsigned)__builtin_amdgcn_s_getreg((3 << 11) | 20) & 0xFu; }
#define XB_SPIN(cond, bar) do { unsigned _sp = 0; while (cond) { __builtin_amdgcn_s_sleep(1); \
    if ((++_sp & 255u) == 0u) { if (xb_ld(&(bar)[XB_TMO])) break; if (_sp > XB_SPIN_CAP) { atomicAdd(&(bar)[XB_TMO], 1u); break; } } } } while (0)

struct XcdBarrier {
    unsigned* bar; unsigned x;
    volatile LAS unsigned* st;
};

__device__ __forceinline__ XcdBarrier xcd_barrier_post(unsigned* bar, volatile LAS unsigned* st) {
    XcdBarrier b; b.bar = bar; b.x = xb_xcc_id(); b.st = st;
    if (threadIdx.x == 0) (void)xb_add(&bar[XB_XCNT(b.x)], 1u);
    return b;
}
__device__ __forceinline__ void xcd_barrier_complete(unsigned* bar, unsigned x, unsigned& nloc, unsigned& nx) {
    const unsigned G = gridDim.x * gridDim.y * gridDim.z;
    unsigned sum, cnt, mine, sp = 0u;
    for (;;) {
        sum = 0u; cnt = 0u; mine = 0u;
#pragma unroll
        for (unsigned j = 0; j < 16; ++j) { const unsigned c = xb_ld(&bar[XB_XCNT(j)]); sum += c; cnt += (c > 0u) ? 1u : 0u; mine = (j == x) ? c : mine; }
        if (sum == G) break;
        __builtin_amdgcn_s_sleep(1);
        if ((++sp & 255u) == 0u) { if (xb_ld(&bar[XB_TMO])) break; if (sp > XB_SPIN_CAP) { atomicAdd(&bar[XB_TMO], 1u); break; } }
    }
    nloc = mine > 0u ? mine : 1u; nx = cnt > 0u ? cnt : 1u;
}

__device__ __forceinline__ void xcd_barrier(const XcdBarrier& b) {
    asm volatile("s_waitcnt vmcnt(0)" ::: "memory");
    __syncthreads();
    if (threadIdx.x == 0) {
        unsigned* bar = b.bar;
        __builtin_amdgcn_s_waitcnt(0);
        unsigned nloc = b.st[0], nx = b.st[1];
        if (nloc == 0u) { xcd_barrier_complete(bar, b.x, nloc, nx); b.st[0] = nloc; b.st[1] = nx; }
        const unsigned old = xb_add(&bar[XB_XSUB(b.x)], 1u);
        const unsigned gen = old / nloc;
        if (old + 1u == (gen + 1u) * nloc) {
            __builtin_amdgcn_fence(__ATOMIC_RELEASE, "agent");
            asm volatile("s_waitcnt vmcnt(0)" ::: "memory");
            const unsigned og = xb_add(&bar[XB_TOP], 1u);
            const unsigned tg = og / nx;
            if (og + 1u == (tg + 1u) * nx) xb_add(&bar[XB_TOPGEN], 1u);
            else XB_SPIN(xb_ld(&bar[XB_TOPGEN]) == tg, bar);
            __builtin_amdgcn_fence(__ATOMIC_ACQUIRE, "agent");
            xb_add(&bar[XB_XGEN(b.x)], 1u);
            asm volatile("s_waitcnt vmcnt(0)" ::: "memory");
        } else {
            XB_SPIN(xb_ld(&bar[XB_XGEN(b.x)]) == gen, bar);
            __builtin_amdgcn_fence(__ATOMIC_ACQUIRE, "agent");
            asm volatile("s_waitcnt vmcnt(0)" ::: "memory");
        }
    }
    __syncthreads();
}

struct Ctx {
    Params P; char* lds; int tid, lane, wave, G, bid, gw, NGW, vcu;
    float* X; bf16_t *Hb, *PROJ, *ATT, *HID, *WinE, *WoutE, *WinO, *WoutO, *Wup, *Wdn; float *ropeC, *ropeS, *axC, *axS, *rss;
};
__device__ __forceinline__ void ctx_init(Ctx& C, const Params& P, char* lds) {
    C.P = P; C.lds = lds; C.tid = threadIdx.x; C.lane = C.tid & 63; C.wave = __builtin_amdgcn_readfirstlane(C.tid >> 6);
    C.G = gridDim.x; C.bid = blockIdx.x; C.vcu = (C.G % 8 == 0) ? (C.bid % 8) * (C.G / 8) + C.bid / 8 : C.bid; C.gw = C.bid * NWAVES + C.wave; C.NGW = C.G * NWAVES;
    unsigned char* ws = P.ws; C.X = P.out;
    C.Hb = (bf16_t*)(ws + WS_H); C.PROJ = (bf16_t*)(ws + WS_PROJ); C.ATT = (bf16_t*)(ws + WS_ATT); C.HID = (bf16_t*)(ws + WS_HID);
    C.WinE = (bf16_t*)(ws + WS_WINE); C.WoutE = (bf16_t*)(ws + WS_WOUTE); C.WinO = (bf16_t*)(ws + WS_WINO); C.WoutO = (bf16_t*)(ws + WS_WOUTO);
    C.Wup = (bf16_t*)(ws + WS_WUP); C.Wdn = (bf16_t*)(ws + WS_WDN);
    C.ropeC = (float*)(ws + WS_ROPE_C); C.ropeS = (float*)(ws + WS_ROPE_S); C.axC = (float*)(ws + WS_AX_C); C.axS = (float*)(ws + WS_AX_S); C.rss = (float*)(ws + WS_RSS);
}

__device__ __forceinline__ void ph_prologue(const Ctx& C) {
    const Params& P = C.P; const int lane = C.lane;
    float* scr = (float*)(C.lds + C.wave * 16384);
    constexpr int I_INE = 16 * (NE / 32), I_SQ = 16 * 32, I_UP = 16 * (FF / 32), I_DN = 64 * 32;
    constexpr int NITEMS = I_INE + I_SQ + I_UP + I_DN;
    for (int it = C.gw; it < NITEMS; it += C.NGW) {
        int r = it;
        if (r < I_INE) { transpose_item(P.in[3], DM, NE, C.WinE, scr, r, lane, 0, P.in[2]); continue; } r -= I_INE;
        if (r < I_SQ) { transpose_item(P.in[7], DM, DM, C.WoutE, scr, r, lane, -1, nullptr); continue; } r -= I_SQ;
        if (r < I_UP) { transpose_item(P.in[17], DM, FF, C.Wup, scr, r, lane, -1, P.in[16]); continue; } r -= I_UP;
        transpose_item(P.in[18], FF, DM, C.Wdn, scr, r, lane, -1, nullptr);
    }
    for (int idx = C.bid * NTHREADS + C.tid; idx < 4096 * 32; idx += C.G * NTHREADS) {
        const int t = idx >> 5, i = idx & 31;
        const float inv = exp2f(-(float)(2 * i) * (1.f / 64.f) * 13.287712379549449f);
        float c, s; cs_of((float)t * inv, c, s); C.ropeC[idx] = c; C.ropeS[idx] = s;
    }
    for (int idx = C.bid * NTHREADS + C.tid; idx < 64 * 16; idx += C.G * NTHREADS) {
        const int p = idx >> 4, i = idx & 15;
        const float inv = exp2f(-(float)(2 * i) * (1.f / 32.f) * 13.287712379549449f);
        float c, s; cs_of((float)p * inv, c, s); C.axC[idx] = c; C.axS[idx] = s;
    }
    for (int m = C.gw; m < MT; m += 2 * C.NGW) {
        const int m2 = m + C.NGW;
        const float* src = (m < MP) ? P.in[0] + (size_t)m * DM : P.in[1] + (size_t)(m - MP) * DM;
        if (m2 < MT) {
            const float* src2 = (m2 < MP) ? P.in[0] + (size_t)m2 * DM : P.in[1] + (size_t)(m2 - MP) * DM;
            cvt_row_bf16_x2(src, src2, C.Hb + (size_t)m * DM, C.Hb + (size_t)m2 * DM, C.rss + (size_t)m * 16, C.rss + (size_t)m2 * 16, lane);
        } else cvt_row_bf16(src, C.Hb + (size_t)m * DM, C.rss + (size_t)m * 16, lane);
    }
}
__device__ __forceinline__ void ph_weights_late(const Ctx& C, int first) {
    const Params& P = C.P; const int lane = C.lane;
    float* scr = (float*)(C.lds + C.wave * 16384);
    constexpr int I_SQ = 16 * 32, I_INO = 16 * (NO / 32), I_UP = 16 * (FF / 32), I_DN = 64 * 32;
    constexpr int NITEMS = I_INO + I_SQ + I_UP + I_DN;
    const int nw = (C.G - first) * NWAVES;
    for (int it = (C.bid - first) * NWAVES + C.wave; it < NITEMS; it += nw) {
        int r = it;
        if (r < I_INO) { transpose_item(P.in[9], DM, NO, C.WinO, scr, r, lane, 1, P.in[8]); continue; } r -= I_INO;
        if (r < I_SQ) { transpose_item(P.in[15], DM, DM, C.WoutO, scr, r, lane, -1, nullptr); continue; } r -= I_SQ;
        if (r < I_UP) { transpose_item(P.in[17] + (size_t)DM * FF, DM, FF, C.Wup + (size_t)DM * FF, scr, r, lane, -1, P.in[16] + DM); continue; } r -= I_UP;
        transpose_item(P.in[18] + (size_t)DM * FF, FF, DM, C.Wdn + (size_t)DM * FF, scr, r, lane, -1, nullptr);
    }
}
template <class Epi>
__device__ __forceinline__ void ph_gemm(const Ctx& C, const bf16_t* A, const bf16_t* Bt, int N, int K, const Epi& E) {
    pg8::Gemm g{A, Bt, MT, N, K}; pg8::StaticOrder S; S.init(MT, N, C.G, C.bid);
    pg8::gemm_phase<Epi, pg8::StaticOrder, PG8_ALIGN, PG8_SP2>((PG8_LAS unsigned char*)C.lds, g, S, E);
}
__device__ __forceinline__ void ph_norm(const Ctx& C, const float* g) {
    for (int m = C.gw; m < MT; m += C.NGW) rms_row_bf16(C.X + (size_t)m * DM, g, C.Hb + (size_t)m * DM, nullptr, C.lane);
}
__device__ __forceinline__ void ph_final(const Ctx& C) {
    for (int m = C.gw; m < MT; m += 2 * C.NGW) {
        const int m2 = m + C.NGW;
        if (m2 < MT) final_row_x2(C.Hb + (size_t)m * DM, C.Hb + (size_t)m2 * DM, pg8::row_rstd(C.rss + (size_t)4 * RS, m), pg8::row_rstd(C.rss + (size_t)4 * RS, m2), C.P.in[19], C.X + (size_t)m * DM, C.X + (size_t)m2 * DM, C.lane);
        else final_row(C.Hb + (size_t)m * DM, pg8::row_rstd(C.rss + (size_t)4 * RS, m), C.P.in[19], C.X + (size_t)m * DM, C.lane);
    }
}
__device__ __forceinline__ void ph_qk_axial(const Ctx& C) {
    const int lane = C.lane, hs = lane >> 5, p = lane & 31;
    const int dlo = (p < 16) ? p : (16 + p), dhi = dlo + 16, fi = p & 15;
    const float* gq = C.P.in[5]; const float* gk = C.P.in[6];
    const float gq_lo = gq[dlo], gq_hi = gq[dhi], gk_lo = gk[dlo], gk_hi = gk[dhi];
    for (int m = C.gw; m < MT; m += C.NGW) {
        const int t = (m < MP) ? (m & 2047) : ((m - MP) & 4095);
        const int pos = (p < 16) ? (t >> 6) : (t & 63);
        const float c = C.axC[pos * 16 + fi], s = C.axS[pos * 16 + fi];
        bf16_t* row = C.PROJ + (size_t)m * NE;
#pragma unroll
        for (int it = 0; it < 5; ++it) {
            const int j = 2 * it + hs;
            bf16_t* hp = row + ((j < 8) ? (1536 + 64 * j) : (2048 + 64 * (j - 8)));
            const float a = bf2f(hp[dlo]), b = bf2f(hp[dhi]);
            float ss = a * a + b * b;
            ss += __shfl_xor(ss, 1); ss += __shfl_xor(ss, 2); ss += __shfl_xor(ss, 4); ss += __shfl_xor(ss, 8); ss += __shfl_xor(ss, 16);
            const float rstd = 1.0f / sqrtf(ss * (1.f / 64.f) + 1e-6f);
            const float an = a * rstd * ((j < 8) ? gq_lo : gk_lo), bn = b * rstd * ((j < 8) ? gq_hi : gk_hi);
            hp[dlo] = f2bf(an * c - bn * s); hp[dhi] = f2bf(bn * c + an * s);
        }
    }
}
__device__ __forceinline__ void ph_rope_odd(const Ctx& C) {
    const int lane = C.lane, hs = lane >> 5, p = lane & 31;
    for (int m = C.gw; m < MT; m += C.NGW) {
        const int t = (m < MP) ? (m & 2047) : ((m - MP) & 4095);
        const float c = C.ropeC[t * 32 + p], s = C.ropeS[t * 32 + p];
        bf16_t* row = C.PROJ + (size_t)m * NO;
#pragma unroll 4
        for (int it = 0; it < 16; ++it) {
            bf16_t* hp = row + 64 * (2 * it + hs);
            const float a = bf2f(hp[p]), b = bf2f(hp[p + 32]);
            hp[p] = f2bf(a * c - b * s); hp[p + 32] = f2bf(b * c + a * s);
        }
    }
}
__device__ __forceinline__ void ph_attn_gqa(const Ctx& C) {
    const float sc = 0.125f * LOG2E;
    const int lane = C.lane, wave = C.wave, r32 = lane & 31, hi = lane >> 5;
    for (int u = C.vcu; u < 2560; u += C.G) {
        int b, h, qb, T, rowbase; seq_of_unit(u, b, h, qb, T, rowbase);
        const size_t qrow0 = (size_t)rowbase + qb * 256 + wave * 32;
        const bf16_t* Qw = C.PROJ + qrow0 * NE + 1536 + 64 * h;
        const bf16_t* Kh = C.PROJ + (size_t)rowbase * NE + 2048 + 64 * (h >> 2);
        const bf16_t* Vh = C.PROJ + (size_t)rowbase * NE + 2176 + 64 * (h >> 2);
        f32x16 o[2]; float l;
        flash_pass_dense<64>(C.lds, Qw, Kh, Vh, NE, T / 64, sc, o, l);
        store_o64(o, 1.0f / l, C.ATT + (qrow0 + r32) * DM + 512 + 64 * h, hi);
    }
}
__device__ __forceinline__ void ph_attn_na(const Ctx& C) {
    const float sc = 0.125f * LOG2E;
    const int lane = C.lane, wave = C.wave, r32 = lane & 31, hi = lane >> 5;
    for (int u = C.vcu; u < 2560; u += C.G) {
        int b, h, qb, T, rowbase; seq_of_unit(u, b, h, qb, T, rowbase);
        const int rows = T / 64, R0 = qb * 4, r = R0 + (wave >> 1);
        const int tb = min(max(R0 - 4, 0), rows - 8), te = min(max(R0 + 3 - 4, 0), rows - 8) + 8;
        const int wb = min(max(r - 4, 0), rows - 8), we = wb + 8;
        for (int i = C.tid; i < 465; i += NTHREADS) ((float*)(C.lds + A_RPB))[i] = C.P.in[4][h * 465 + i] * LOG2E;
        const size_t qrow0 = (size_t)rowbase + qb * 256 + wave * 32;
        const bf16_t* Qw = C.PROJ + qrow0 * NE + 64 * h;
        const bf16_t* Kh = C.PROJ + (size_t)rowbase * NE + 512 + 64 * h;
        const bf16_t* Vh = C.PROJ + (size_t)rowbase * NE + 1024 + 64 * h;
        f32x16 o[2]; float l;
        flash_pass<64, true>(C.lds, Qw, Kh, Vh, NE, tb, te, wb, we, sc, 32 * (wave & 1), r, o, l);
        store_o64(o, 1.0f / l, C.ATT + (qrow0 + r32) * DM + 64 * h, hi);
    }
}
__device__ __forceinline__ void ph_diff(const Ctx& C) {
    const float sc = 0.125f * LOG2E;
    const int lane = C.lane, wave = C.wave, r32 = lane & 31, hi = lane >> 5;
    const float lam_init = 0.8f - 0.6f * 0.7408182206817179f;
    const float s1 = wave_sum(C.P.in[10][lane] * C.P.in[11][lane]), s2 = wave_sum(C.P.in[12][lane] * C.P.in[13][lane]);
    const float lam = __expf(s1) - __expf(s2) + lam_init;
    for (int u = C.vcu; u < 2560; u += C.G) {
        int b, h, qb, T, rowbase; seq_of_unit(u, b, h, qb, T, rowbase);
        const size_t qrow0 = (size_t)rowbase + qb * 256 + wave * 32;
        const bf16_t* Vh = C.PROJ + (size_t)rowbase * NO + 2048 + 128 * h;
        unsigned* stash = (unsigned*)(C.lds + A_STASH + wave * 8192) + lane;
        {
            f32x16 o[4]; float l;
            flash_pass_dense<128>(C.lds, C.PROJ + qrow0 * NO + 64 * (2 * h), C.PROJ + (size_t)rowbase * NO + 1024 + 64 * (2 * h), Vh, NO, T / 64, sc, o, l);
            const float inv = 1.0f / l;
#pragma unroll
            for (int db = 0; db < 4; ++db)
#pragma unroll
                for (int j = 0; j < 8; ++j) stash[(db * 8 + j) * 64] = pk2(o[db][2 * j] * inv, o[db][2 * j + 1] * inv);
        }
        f32x16 o[4]; float l;
        flash_pass_dense<128>(C.lds, C.PROJ + qrow0 * NO + 64 * (2 * h + 1), C.PROJ + (size_t)rowbase * NO + 1024 + 64 * (2 * h + 1), Vh, NO, T / 64, sc, o, l);
        const float inv = lam / l;
        float ss = 0.f;
#pragma unroll
        for (int db = 0; db < 4; ++db)
#pragma unroll
            for (int j = 0; j < 8; ++j) {
                const unsigned pk = stash[(db * 8 + j) * 64];
                const float a = bf_lo(pk) - o[db][2 * j] * inv, c = bf_hi(pk) - o[db][2 * j + 1] * inv;
                o[db][2 * j] = a; o[db][2 * j + 1] = c; ss += a * a + c * c;
            }
        ss += __shfl_xor(ss, 32);
        const float rstd = (1.0f - lam_init) / sqrtf(ss * (1.f / 128.f) + 1e-5f);
        bf16_t* orow = C.ATT + (qrow0 + r32) * DM + 128 * h;
#pragma unroll
        for (int db = 0; db < 4; ++db)
#pragma unroll
            for (int g = 0; g < 4; ++g) {
                const int d = 32 * db + 8 * g + 4 * hi;
                const f32x4 gg = *(const f32x4*)(C.P.in[14] + d);
                u32x2 w; w.x = pk2(o[db][4 * g] * rstd * gg.x, o[db][4 * g + 1] * rstd * gg.y); w.y = pk2(o[db][4 * g + 2] * rstd * gg.z, o[db][4 * g + 3] * rstd * gg.w);
                *(u32x2*)(orow + d) = w;
            }
    }
}
__global__ void __launch_bounds__(NTHREADS) fwd_megakernel(Params P) {
    extern __shared__ __attribute__((aligned(16))) unsigned char lds_raw[];
    cg::grid_group grid = cg::this_grid();
    Ctx C; ctx_init(C, P, (char*)lds_raw);
    volatile LAS unsigned* bst = (volatile LAS unsigned*)((LAS unsigned char*)lds_raw + 140 * 1024);
    if (threadIdx.x == 0) { bst[0] = 0u; bst[1] = 0u; }
    __syncthreads();
    const XcdBarrier bar = xcd_barrier_post((unsigned*)(P.ws + WS_BAR), bst);
    ph_prologue(C);
    if (P.ws == nullptr) grid.sync();
    xcd_barrier(bar);
    ph_gemm(C, C.Hb, C.WinE, NE, DM, pg8::EpiProj<0>{C.PROJ, NE, C.axC, C.axS, P.in[5], P.in[6], MP, C.rss});
    if (C.G == 256 && C.bid >= 64) ph_weights_late(C, 64);
    else if (C.G != 256) ph_weights_late(C, 0);
    xcd_barrier(bar);
    ph_attn_gqa(C);
    ph_attn_na(C);
    xcd_barrier(bar);
    ph_gemm(C, C.ATT, C.WoutE, DM, DM, pg8::EpiResid{nullptr, nullptr, MP, DM, C.Hb, C.rss + RS});
    xcd_barrier(bar);
    ph_gemm(C, C.Hb, C.Wup, FF, DM, pg8::EpiBf16<2>{C.HID, FF, C.rss + RS});
    xcd_barrier(bar);
    ph_gemm(C, C.HID, C.Wdn, DM, FF, pg8::EpiResid{nullptr, nullptr, MP, DM, C.Hb, C.rss + 2 * RS});
    xcd_barrier(bar);
    ph_gemm(C, C.Hb, C.WinO, NO, DM, pg8::EpiProj<1>{C.PROJ, NO, C.ropeC, C.ropeS, nullptr, nullptr, MP, C.rss + 2 * RS});
    xcd_barrier(bar);
    ph_diff(C);
    xcd_barrier(bar);
    ph_gemm(C, C.ATT, C.WoutO, DM, DM, pg8::EpiResid{nullptr, nullptr, MP, DM, C.Hb, C.rss + 3 * RS});
    xcd_barrier(bar);
    ph_gemm(C, C.Hb, C.Wup + (size_t)DM * FF, FF, DM, pg8::EpiBf16<2>{C.HID, FF, C.rss + 3 * RS});
    xcd_barrier(bar);
    ph_gemm(C, C.HID, C.Wdn + (size_t)DM * FF, DM, FF, pg8::EpiResid{nullptr, nullptr, MP, DM, C.Hb, C.rss + 4 * RS});
    xcd_barrier(bar);
    ph_final(C);
}

extern "C" void kernel_launch(void* const* d_in, const int* in_sizes, int n_in, void* d_out, int out_size, void* d_ws, size_t ws_size, hipStream_t stream) {
    static int grid = 0;
    if (grid == 0) {
        if (n_in != 20 || out_size != MT * DM || ws_size < WS_END) { fprintf(stderr, "kernel_launch: unexpected shapes (n_in %d out %d ws %zu)\n", n_in, out_size, ws_size); grid = -1; return; }
        int dev = 0, cus = 0, per_cu = 0;
        hipGetDevice(&dev);
        hipDeviceGetAttribute(&cus, hipDeviceAttributeMultiprocessorCount, dev);
        if (hipFuncSetAttribute((const void*)fwd_megakernel, hipFuncAttributeMaxDynamicSharedMemorySize, LDS_BYTES) != hipSuccess) { fprintf(stderr, "kernel_launch: hipFuncSetAttribute failed\n"); }
        if (hipOccupancyMaxActiveBlocksPerMultiprocessor(&per_cu, (const void*)fwd_megakernel, NTHREADS, LDS_BYTES) != hipSuccess || per_cu < 1) { fprintf(stderr, "kernel_launch: occupancy query gave %d\n", per_cu); per_cu = 1; }
        (void)hipGetLastError();
        grid = cus * per_cu;
    }
    if (grid < 0) return;
    if (hipMemsetAsync((char*)d_ws + WS_BAR, 0, BAR_BYTES, stream) != hipSuccess) { fprintf(stderr, "kernel_launch: memset of the barrier words failed\n"); return; }
    Params p{};
    for (int i = 0; i < 20; ++i) p.in[i] = (const float*)d_in[i];
    p.out = (float*)d_out; p.ws = (unsigned char*)d_ws;
    void* args[] = {&p};
    hipError_t e = hipLaunchCooperativeKernel((const void*)fwd_megakernel, dim3(grid), dim3(NTHREADS), args, LDS_BYTES, stream);
    if (e != hipSuccess) fprintf(stderr, "cooperative launch failed: %s (grid %d)\n", hipGetErrorString(e), grid);
}
```
